# Optimizing an MI355X kernel written in HIP

```python
import math
import jax, jax.numpy as jnp
from jax import lax
import numpy as np

D_MODEL = 1024
BATCH = 8
SEQ = 2048
DEPTH = 2
DEC_BATCH = 128
DEC_SEQ = 1
PAST_LEN = 16384
PAGE_SIZE = 128

DN_ALPHA = (2 * DEPTH) ** 0.25
DN_BETA = (8 * DEPTH) ** -0.25
LN_EPS = 1e-5
GDN_HEADS = 4
GDN_DK = 128
GDN_DV = 128
GDN_WIDTH = GDN_HEADS * GDN_DK
SCONV_W = 4
GDN_CHUNK = 64
CC_CH = D_MODEL // 2
CC_W = 31
GM_WIDTH = D_MODEL
GM_GROUPS = 4
GM_CHUNK = 128
N_MEM = 256
XA_HEADS = 4
XA_HEAD_DIM = D_MODEL // XA_HEADS
D_FF = 2816
AB_IN = 4 * GDN_WIDTH + 2 * GDN_HEADS + 2 * CC_CH

kernel_name = "hybrid_gdn_conformer_gmlp_decoder_step"


def layer_norm(x, g, b):
    xf = x.astype(jnp.float32)
    mu = jnp.mean(xf, -1, keepdims=True)
    var = jnp.mean(jnp.square(xf - mu), -1, keepdims=True)
    return ((xf - mu) * lax.rsqrt(var + LN_EPS) * g.astype(jnp.float32) + b.astype(jnp.float32)).astype(x.dtype)


def rms_norm(x, g):
    xf = x.astype(jnp.float32)
    return xf * lax.rsqrt(jnp.mean(xf * xf, -1, keepdims=True) + 1e-6) * g.astype(jnp.float32)


def l2_normalize(x):
    xf = x.astype(jnp.float32)
    return xf * lax.rsqrt(jnp.sum(xf * xf, -1, keepdims=True) + 1e-6)


def swiglu(x, wg, wu, wd):
    return (jax.nn.silu(x @ wg) * (x @ wu)) @ wd


def causal_depthwise_conv(x, buf, w):
    xx = jnp.concatenate([buf.astype(x.dtype), x], axis=1)
    y = lax.conv_general_dilated(xx, w[:, None, :].astype(x.dtype), (1,), 'VALID',
                                 dimension_numbers=('NWC', 'WIO', 'NWC'),
                                 feature_group_count=x.shape[-1])
    return y, xx[:, xx.shape[1] - (w.shape[0] - 1):]


def gated_delta_rule(q, k, v, g, beta, S0):
    N, L, H, dk = k.shape
    dv = v.shape[-1]
    c = min(GDN_CHUNK, L)
    pad = (-L) % c
    f32 = jnp.float32
    q, k, v, g, beta = (t.astype(f32) for t in (q, k, v, g, beta))
    if pad:
        q, k, v = (jnp.pad(t, ((0, 0), (0, pad), (0, 0), (0, 0))) for t in (q, k, v))
        g, beta = (jnp.pad(t, ((0, 0), (0, pad), (0, 0))) for t in (g, beta))
    n = (L + pad) // c
    chunks = lambda t: t.reshape(N, n, c, H, -1).transpose(0, 3, 1, 2, 4)
    q, k, v = chunks(q), chunks(k), chunks(v)
    g = jnp.cumsum(g.reshape(N, n, c, H).transpose(0, 3, 1, 2), axis=-1)
    beta = beta.reshape(N, n, c, H).transpose(0, 3, 1, 2)
    causal = jnp.tril(jnp.ones((c, c), bool))
    strict = jnp.tril(jnp.ones((c, c), bool), -1)
    diff = g[..., :, None] - g[..., None, :]
    decay = jnp.where(causal, jnp.exp(jnp.where(causal, diff, 0.0)), 0.0)
    kb = k * beta[..., None]
    M = jnp.where(strict, jnp.einsum('bhnid,bhnjd->bhnij', kb, k) * decay, 0.0)
    A = M + jnp.eye(c, dtype=f32)
    rhs = jnp.concatenate([v * beta[..., None], kb * jnp.exp(g)[..., None]], axis=-1)
    sol = lax.linalg.triangular_solve(A, rhs, left_side=True, lower=True, unit_diagonal=True)
    u, w = sol[..., :dv], sol[..., dv:]
    qk = jnp.einsum('bhnid,bhnjd->bhnij', q, k) * decay
    q_g = q * jnp.exp(g)[..., None]
    k_tail = k * jnp.exp(g[..., -1:] - g)[..., None]
    g_last = jnp.exp(g[..., -1])

    def step(S, inp):
        qg_i, kt_i, u_i, w_i, qk_i, gl_i = inp
        v_new = u_i - jnp.einsum('bhcd,bhde->bhce', w_i, S)
        o = jnp.einsum('bhcd,bhde->bhce', qg_i, S) + jnp.einsum('bhij,bhje->bhie', qk_i, v_new)
        S = S * gl_i[..., None, None] + jnp.einsum('bhcd,bhce->bhde', kt_i, v_new)
        return S, o

    xs = tuple(jnp.moveaxis(t, 2, 0) for t in (q_g, k_tail, u, w, qk, g_last))
    S, o = lax.scan(step, S0.astype(f32), xs)
    o = jnp.moveaxis(o, 0, 2).transpose(0, 2, 3, 1, 4).reshape(N, n * c, H, dv)[:, :L]
    return o, S


def gdn_conformer_mixer(h, p, dn_S, dn_conv, cc_conv):
    N, L, _ = h.shape
    proj = h @ p['ab_w_in']
    qkv_raw, z, b_raw, a_raw, glu_in = jnp.split(
        proj, [3 * GDN_WIDTH, 4 * GDN_WIDTH, 4 * GDN_WIDTH + GDN_HEADS, 4 * GDN_WIDTH + 2 * GDN_HEADS], axis=-1)
    qkv, new_dn_conv = causal_depthwise_conv(qkv_raw, dn_conv, p['dn_conv_w'])
    qkv = jax.nn.silu(qkv)
    q, k, v = jnp.split(qkv, 3, axis=-1)
    q = l2_normalize(q.reshape(N, L, GDN_HEADS, GDN_DK)) * (GDN_DK ** -0.5)
    k = l2_normalize(k.reshape(N, L, GDN_HEADS, GDN_DK))
    v = v.reshape(N, L, GDN_HEADS, GDN_DV)
    beta = jax.nn.sigmoid(b_raw.astype(jnp.float32))
    g = -jnp.exp(p['dn_A_log'].astype(jnp.float32)) * jax.nn.softplus(
        a_raw.astype(jnp.float32) + p['dn_dt_bias'].astype(jnp.float32))
    o, new_S = gated_delta_rule(q, k, v, g, beta, dn_S)
    o = rms_norm(o, p['dn_norm_g']) * jax.nn.silu(z.reshape(N, L, GDN_HEADS, GDN_DV).astype(jnp.float32))
    o = o.reshape(N, L, GDN_WIDTH).astype(h.dtype)
    ga, gb = jnp.split(glu_in, 2, axis=-1)
    glu = ga * jax.nn.sigmoid(gb)
    c, new_cc_conv = causal_depthwise_conv(glu, cc_conv, p['cc_conv_w'])
    c = jax.nn.silu(layer_norm(c + p['cc_conv_b'], p['cc_ln_g'], p['cc_ln_b']))
    y = jnp.concatenate([o, c], axis=-1) @ p['ab_w_out']
    return y, new_S.astype(dn_S.dtype), new_dn_conv, new_cc_conv


def chunk_spatial_mix(v, w_s, b_s):
    N, L, C = v.shape
    pad = (-L) % GM_CHUNK
    vp = jnp.pad(v, ((0, 0), (0, pad), (0, 0)))
    n = (L + pad) // GM_CHUNK
    vg = vp.reshape(N, n, GM_CHUNK, GM_GROUPS, C // GM_GROUPS)
    w = jnp.where(jnp.tril(jnp.ones((GM_CHUNK, GM_CHUNK), bool)), w_s, 0.0).astype(v.dtype)
    f = jnp.einsum('gij,bnjgc->bnigc', w, vg) + jnp.transpose(b_s)[:, :, None]
    return f.reshape(N, n * GM_CHUNK, C)[:, :L]


def chunk_mlp_mixer(h, p):
    pr = jax.nn.gelu(h @ p['gm_w_in'])
    u, v = jnp.split(pr, 2, axis=-1)
    v = layer_norm(v, p['gm_ln_g'], p['gm_ln_b'])
    f = chunk_spatial_mix(v, p['gm_w_s'], p['gm_b_s'])
    return (u * f) @ p['gm_w_out'], v


def cross_attend(h, mk, mv, wq, wo):
    N, L, _ = h.shape
    q = (h @ wq).reshape(N, L, XA_HEADS, XA_HEAD_DIM)
    s = jnp.einsum('blhd,bmhd->bhlm', q, mk.astype(h.dtype)).astype(jnp.float32) * (XA_HEAD_DIM ** -0.5)
    pr = jax.nn.softmax(s, axis=-1).astype(h.dtype)
    o = jnp.einsum('bhlm,bmhd->blhd', pr, mv.astype(h.dtype)).reshape(N, L, D_MODEL)
    return o @ wo


def trunk(x, mem_k, mem_v, dn_S, dn_conv, cc_conv, p):
    gm_v = None
    for l in range(DEPTH):
        x = layer_norm(DN_ALPHA * x + 0.5 * swiglu(x, p['ffn_w_gate'][l, 0], p['ffn_w_up'][l, 0], p['ffn_w_down'][l, 0]),
                       p['ln_g'][l, 0], p['ln_b'][l, 0])
        if l % 2 == 0:
            mix, dn_S, dn_conv, cc_conv = gdn_conformer_mixer(x, p, dn_S, dn_conv, cc_conv)
        else:
            mix, gm_v = chunk_mlp_mixer(x, p)
        x = layer_norm(DN_ALPHA * x + mix, p['ln_g'][l, 1], p['ln_b'][l, 1])
        x = layer_norm(DN_ALPHA * x + cross_attend(x, mem_k[l], mem_v[l], p['xa_wq'][l], p['xa_wo'][l]),
                       p['ln_g'][l, 2], p['ln_b'][l, 2])
        x = layer_norm(DN_ALPHA * x + 0.5 * swiglu(x, p['ffn_w_gate'][l, 1], p['ffn_w_up'][l, 1], p['ffn_w_down'][l, 1]),
                       p['ln_g'][l, 3], p['ln_b'][l, 3])
    return x, dn_S, dn_conv, cc_conv, gm_v


def setup_inputs(seed: int = 0) -> dict:
    key = jax.random.key(seed)
    ks = iter(jax.random.split(key, 48))
    nrm = lambda shape, scale: scale * jax.random.normal(next(ks), shape, jnp.float32)
    dense = lambda shape, s=1.0: nrm(shape, s * shape[-2] ** -0.5)
    dt = jnp.exp(jax.random.uniform(next(ks), (GDN_HEADS,), jnp.float32, math.log(1e-3), math.log(1e-1)))
    inp = {
        'x_prompt': nrm((BATCH, SEQ, D_MODEL), 1.0),
        'x_sample': nrm((DEC_BATCH, DEC_SEQ, D_MODEL), 1.0),
        'mem_prompt': nrm((BATCH, N_MEM, D_MODEL), 1.0),
        'cache_mem_k': nrm((DEPTH, DEC_BATCH, N_MEM, XA_HEADS, XA_HEAD_DIM), 1.0),
        'cache_mem_v': nrm((DEPTH, DEC_BATCH, N_MEM, XA_HEADS, XA_HEAD_DIM), 1.0),
        'state_dn_S': nrm((DEC_BATCH, GDN_HEADS, GDN_DK, GDN_DV), 0.1),
        'state_dn_conv': nrm((DEC_BATCH, SCONV_W - 1, 3 * GDN_WIDTH), 1.0),
        'state_cc_conv': nrm((DEC_BATCH, CC_W - 1, CC_CH), 0.5),
        'ln_g': 1.0 + nrm((DEPTH, 4, D_MODEL), 0.02),
        'ln_b': nrm((DEPTH, 4, D_MODEL), 0.02),
        'ffn_w_gate': dense((DEPTH, 2, D_MODEL, D_FF)),
        'ffn_w_up': dense((DEPTH, 2, D_MODEL, D_FF)),
        'ffn_w_down': dense((DEPTH, 2, D_FF, D_MODEL), DN_BETA),
        'xa_wq': dense((DEPTH, D_MODEL, D_MODEL)),
        'xa_wk': dense((DEPTH, D_MODEL, D_MODEL)),
        'xa_wv': dense((DEPTH, D_MODEL, D_MODEL)),
        'xa_wo': dense((DEPTH, D_MODEL, D_MODEL), DN_BETA),
        'ab_w_in': dense((D_MODEL, AB_IN)),
        'dn_conv_w': nrm((SCONV_W, 3 * GDN_WIDTH), SCONV_W ** -0.5),
        'dn_A_log': jnp.log(jax.random.uniform(next(ks), (GDN_HEADS,), jnp.float32, 1.0, 16.0)),
        'dn_dt_bias': dt + jnp.log(-jnp.expm1(-dt)),
        'dn_norm_g': 1.0 + nrm((GDN_DV,), 0.02),
        'cc_conv_w': nrm((CC_W, CC_CH), CC_W ** -0.5),
        'cc_conv_b': nrm((CC_CH,), 0.02),
        'cc_ln_g': 1.0 + nrm((CC_CH,), 0.02),
        'cc_ln_b': nrm((CC_CH,), 0.02),
        'ab_w_out': dense((GDN_WIDTH + CC_CH, D_MODEL), DN_BETA),
        'gm_w_in': dense((D_MODEL, 2 * GM_WIDTH)),
        'gm_ln_g': 1.0 + nrm((GM_WIDTH,), 0.02),
        'gm_ln_b': nrm((GM_WIDTH,), 0.02),
        'gm_w_s': nrm((GM_GROUPS, GM_CHUNK, GM_CHUNK), GM_CHUNK ** -0.5),
        'gm_b_s': 1.0 + nrm((GM_GROUPS, GM_CHUNK), 0.02),
        'gm_w_out': dense((GM_WIDTH, D_MODEL), DN_BETA),
    }
    return inp


def reference(x_prompt, x_sample, mem_prompt, cache_mem_k, cache_mem_v, state_dn_S, state_dn_conv, state_cc_conv,
              ln_g, ln_b, ffn_w_gate, ffn_w_up, ffn_w_down, xa_wq, xa_wk, xa_wv, xa_wo,
              ab_w_in, dn_conv_w, dn_A_log, dn_dt_bias, dn_norm_g, cc_conv_w, cc_conv_b, cc_ln_g, cc_ln_b, ab_w_out,
              gm_w_in, gm_ln_g, gm_ln_b, gm_w_s, gm_b_s, gm_w_out):
    p = dict(ln_g=ln_g, ln_b=ln_b, ffn_w_gate=ffn_w_gate, ffn_w_up=ffn_w_up, ffn_w_down=ffn_w_down,
             xa_wq=xa_wq, xa_wo=xa_wo, ab_w_in=ab_w_in, dn_conv_w=dn_conv_w, dn_A_log=dn_A_log,
             dn_dt_bias=dn_dt_bias, dn_norm_g=dn_norm_g, cc_conv_w=cc_conv_w, cc_conv_b=cc_conv_b,
             cc_ln_g=cc_ln_g, cc_ln_b=cc_ln_b, ab_w_out=ab_w_out, gm_w_in=gm_w_in, gm_ln_g=gm_ln_g,
             gm_ln_b=gm_ln_b, gm_w_s=gm_w_s, gm_b_s=gm_b_s, gm_w_out=gm_w_out)
    B = x_prompt.shape[0]
    dt = x_prompt.dtype
    mem_k_prompt = jnp.einsum('bmd,lde->lbme', mem_prompt, xa_wk).reshape(DEPTH, B, N_MEM, XA_HEADS, XA_HEAD_DIM)
    mem_v_prompt = jnp.einsum('bmd,lde->lbme', mem_prompt, xa_wv).reshape(DEPTH, B, N_MEM, XA_HEADS, XA_HEAD_DIM)
    y_prompt, dn_S_prompt, dn_conv_prompt, cc_conv_prompt, _ = trunk(
        x_prompt, mem_k_prompt, mem_v_prompt,
        jnp.zeros((B, GDN_HEADS, GDN_DK, GDN_DV), dt),
        jnp.zeros((B, SCONV_W - 1, 3 * GDN_WIDTH), dt),
        jnp.zeros((B, CC_W - 1, CC_CH), dt), p)
    y_sample, dn_S_sample, dn_conv_sample, cc_conv_sample, gm_v_sample = trunk(
        x_sample, cache_mem_k, cache_mem_v, state_dn_S, state_dn_conv, state_cc_conv, p)
    return (y_prompt, y_sample, mem_k_prompt, mem_v_prompt, dn_S_prompt, dn_conv_prompt, cc_conv_prompt,
            dn_S_sample, dn_conv_sample, cc_conv_sample, gm_v_sample)
```

```cpp
#include <hip/hip_runtime.h>
#include <hip/hip_cooperative_groups.h>
#include <cstdio>
#include <cstdint>
namespace cg = cooperative_groups;

#ifndef N_PER_PHASE_LAUNCH
#define N_PER_PHASE_LAUNCH 0
#endif

#define LAS __attribute__((address_space(3)))
typedef unsigned short bf16_t;
typedef short bf16x8 __attribute__((ext_vector_type(8)));
typedef float f32x4 __attribute__((ext_vector_type(4)));
typedef float f32x2 __attribute__((ext_vector_type(2)));
typedef unsigned u32x4 __attribute__((ext_vector_type(4)));
typedef unsigned u32x2 __attribute__((ext_vector_type(2)));

constexpr int D = 1024, FF = 2816, MP = 16384, MS = 128, MV = 16512, MT = 16640, SEQ = 2048, NB = 8;
constexpr int ABN = 3328;
constexpr float ALPHA = 1.4142135623730951f;
constexpr float LN_EPS = 1e-5f;
constexpr int LDS_STAGE = 131072;
constexpr int LDS_BYTES = LDS_STAGE + 64;
constexpr int NPHASES = 34;

constexpr size_t al256(size_t x) { return (x + 255) & ~(size_t)255; }
constexpr size_t WS_WGU = 0;
constexpr size_t WS_WDN = al256(WS_WGU + (size_t)4 * 5632 * 1024 * 2);
constexpr size_t WS_WQ = al256(WS_WDN + (size_t)4 * 1024 * 2816 * 2);
constexpr size_t WS_WO = al256(WS_WQ + (size_t)2 * 1024 * 1024 * 2);
constexpr size_t WS_WKV = al256(WS_WO + (size_t)2 * 1024 * 1024 * 2);
constexpr size_t WS_WABIN = al256(WS_WKV + (size_t)4096 * 1024 * 2);
constexpr size_t WS_WABOUT = al256(WS_WABIN + (size_t)ABN * 1024 * 2);
constexpr size_t WS_WGMIN = al256(WS_WABOUT + (size_t)1024 * 1024 * 2);
constexpr size_t WS_WGMOUT = al256(WS_WGMIN + (size_t)2048 * 1024 * 2);
constexpr size_t WS_WGMS = al256(WS_WGMOUT + (size_t)1024 * 1024 * 2);
constexpr size_t WS_MEMB = al256(WS_WGMS + (size_t)4 * 128 * 128 * 2);
constexpr size_t WS_KB = al256(WS_MEMB + (size_t)2048 * 1024 * 2);
constexpr size_t WS_VT = al256(WS_KB + (size_t)2 * 8 * 256 * 1024 * 2);
constexpr size_t WS_XRES = al256(WS_VT + (size_t)2 * 8 * 1024 * 256 * 2);
constexpr size_t WS_XB = al256(WS_XRES + (size_t)MT * 1024 * 4);
constexpr size_t WS_T = al256(WS_XB + (size_t)MT * 1024 * 2);
constexpr size_t WS_WIDE = al256(WS_T + (size_t)MT * 1024 * 4);
constexpr size_t WS_OC = al256(WS_WIDE + (size_t)MT * ABN * 2);
constexpr size_t WS_QB0 = al256(WS_OC + (size_t)MT * 1024 * 2);
constexpr size_t WS_PB0 = al256(WS_QB0 + (size_t)MT * 1024 * 2);
constexpr size_t WS_ROWSUM = al256(WS_PB0 + (size_t)MT * 1024 * 2);
constexpr size_t WS_GU = al256(WS_ROWSUM + (size_t)2 * MP * 4 * 4);
constexpr size_t WS_GW = al256(WS_GU + (size_t)1024 * 64 * 128 * 4);
constexpr size_t WS_GQG = al256(WS_GW + (size_t)1024 * 64 * 128 * 2);
constexpr size_t WS_GKTT = al256(WS_GQG + (size_t)1024 * 64 * 128 * 2);
constexpr size_t WS_GQK = al256(WS_GKTT + (size_t)1024 * 128 * 64 * 2);
constexpr size_t WS_GGL = al256(WS_GQK + (size_t)1024 * 64 * 64 * 2);
constexpr size_t WS_ORAW0 = al256(WS_GGL + (size_t)1024 * 32 * 4);
constexpr size_t WS_BAR = al256(WS_ORAW0 + (size_t)MV * 512 * 4);
constexpr size_t WS_PART = al256(WS_BAR + (size_t)3456 * 4);
constexpr size_t WS_END = al256(WS_PART + (size_t)11 * 256 * 1024 * 4);

constexpr size_t WS_PB = WS_T;
constexpr size_t WS_ORAW = WS_T;
constexpr size_t WS_QB = WS_GU;
static_assert((size_t)MV * 512 * 4 <= (size_t)MT * 1024 * 4 && (size_t)MT * 1024 * 2 <= (size_t)1024 * 64 * 128 * 4 + (size_t)1024 * 64 * 128 * 2, "alias slots too small");
constexpr size_t O_Y = 0;
constexpr size_t O_MK = O_Y + (size_t)MV * 1024;
constexpr size_t O_MV = O_MK + (size_t)2 * 8 * 256 * 1024;
constexpr size_t O_DNS_P = O_MV + (size_t)2 * 8 * 256 * 1024;
constexpr size_t O_DNC_P = O_DNS_P + (size_t)8 * 4 * 128 * 128;
constexpr size_t O_CCC_P = O_DNC_P + (size_t)8 * 3 * 1536;
constexpr size_t O_DNS_S = O_CCC_P + (size_t)8 * 30 * 512;
constexpr size_t O_DNC_S = O_DNS_S + (size_t)128 * 4 * 128 * 128;
constexpr size_t O_CCC_S = O_DNC_S + (size_t)128 * 3 * 1536;
constexpr size_t O_GMV_S = O_CCC_S + (size_t)128 * 30 * 512;
constexpr size_t O_END = O_GMV_S + (size_t)128 * 1024;

struct Args {
    const float* in[33];
    float* out;
    unsigned char* ws;
    int ph_lo, ph_hi;
};

typedef const __attribute__((address_space(4))) Args* ArgsP;

typedef __bf16 bf16x2_t __attribute__((ext_vector_type(2)));
__device__ __forceinline__ unsigned cvt_pk_bf16(float lo, float hi) { const f32x2 v = (f32x2){lo, hi}; const bf16x2_t r = __builtin_convertvector(v, bf16x2_t); return __builtin_bit_cast(unsigned, r); }
__device__ __forceinline__ bf16_t f2bf(float f) { return (bf16_t)(cvt_pk_bf16(f, 0.f) & 0xffffu); }
__device__ __forceinline__ float bf2f(bf16_t b) { return __uint_as_float(((unsigned)b) << 16); }
__device__ __forceinline__ float bflo(unsigned w) { return __uint_as_float(w << 16); }
__device__ __forceinline__ float bfhi(unsigned w) { return __uint_as_float(w & 0xffff0000u); }
__device__ __forceinline__ float fexp(float x) { return __builtin_amdgcn_exp2f(x * 1.4426950408889634f); }
__device__ __forceinline__ float siluf(float x) { return x * __builtin_amdgcn_rcpf(1.f + fexp(-x)); }
__device__ __forceinline__ float sigmf(float x) { return __builtin_amdgcn_rcpf(1.f + fexp(-x)); }
__device__ __forceinline__ float geluf(float x) { const float t = 1.5957691216057308f * (x + 0.044715f * x * x * x); return x * __builtin_amdgcn_rcpf(1.f + fexp(-t)); }
__device__ __forceinline__ float wave_sum(float v) {
#pragma unroll
    for (int o = 1; o < 64; o <<= 1) v += __shfl_xor(v, o);
    return v;
}
__device__ __forceinline__ float wave_max(float v) {
#pragma unroll
    for (int o = 1; o < 64; o <<= 1) v = fmaxf(v, __shfl_xor(v, o));
    return v;
}
#define LDS_WAIT() asm volatile("s_waitcnt lgkmcnt(0)" ::: "memory")

constexpr int BM = 256, BK = 64, HALF = 128, HTB = HALF * BK * 2, NXCD = 8, WGM = 8;
__device__ __forceinline__ int lds_byte(int r, int c) { const int st = (r >> 4) * 2 + (c >> 5), rr = r & 15, cc = c & 31, ob = rr * 64 + cc * 2; return st * 1024 + (ob ^ (((ob >> 9) & 1) << 5)); }
__device__ __forceinline__ void stage_rc(int b, int& R, int& C) { const int st = b / 1024, sb = b % 1024, swz = sb ^ (((sb >> 9) & 1) << 5); R = (st >> 1) * 16 + swz / 64; C = (st & 1) * 32 + (swz % 64) / 2; }
__device__ __forceinline__ int perm32(int rho) { const int n = rho >> 4, i = rho & 15; return 8 * (i >> 2) + 4 * n + (i & 3); }

struct GemmP {
    const char* A; const char* B;
    long a_pm, a_pn, b_pb, b_pn, a_ks, b_ks;
    int lda, ldb, nt, nM, nN, pn_mask, pn_shift, nsplit, rev;
};
struct EpiA { float* f0; const float* f1; bf16_t* b0; bf16_t* b1; int ldc; float s0, s1; int flag; };

__device__ __forceinline__ bool unit_next(int i, int nM, int nN, int& pm, int& pn, int rev = 0) {
    const int nwg = nM * nN, G = gridDim.x;
    const long L = (long)i * G + (rev ? G - 1 - (int)blockIdx.x : (int)blockIdx.x); if (L >= nwg) return false;
    int wgid = (int)L; { const int q = nwg / NXCD, r = nwg % NXCD, xcd = wgid % NXCD, off = wgid / NXCD; wgid = (xcd < r ? xcd * (q + 1) : r * (q + 1) + (xcd - r) * q) + off; }
    const int nig = WGM * nN, gid = wgid / nig, fm = gid * WGM, gsz = (nM - fm) < WGM ? (nM - fm) : WGM;
    pm = fm + ((wgid % nig) % gsz); pn = (wgid % nig) / gsz; return true;
}

enum { EPI_SWIGLU = 0, EPI_RES = 1, EPI_BF16 = 2, EPI_KV = 3, EPI_SCORES = 4, EPI_PV = 5, EPI_PART = 6 };

template <int MODE>
__device__ __forceinline__ void epilogue(const f32x4 (&acc)[2][2][4][2], int pm, int pn, int wr, int wc, int fr, int fq, const EpiA& e) {
    const int row0 = pm * BM + wr * 64 + fr;
    if constexpr (MODE == EPI_SWIGLU) {
        const int col0 = pn * 128 + wc * 32 + 8 * fq;
#pragma unroll
        for (int ai = 0; ai < 2; ++ai)
#pragma unroll
            for (int m = 0; m < 4; ++m) {
                const size_t row = (size_t)(row0 + ai * HALF + m * 16);
                float h[8];
#pragma unroll
                for (int n = 0; n < 2; ++n)
#pragma unroll
                    for (int j = 0; j < 4; ++j) h[n * 4 + j] = siluf(acc[ai][0][m][n][j]) * acc[ai][1][m][n][j];
                u32x4 w; w.x = cvt_pk_bf16(h[0], h[1]); w.y = cvt_pk_bf16(h[2], h[3]); w.z = cvt_pk_bf16(h[4], h[5]); w.w = cvt_pk_bf16(h[6], h[7]);
                *(u32x4*)(e.b0 + row * e.ldc + col0) = w;
            }
    } else if constexpr (MODE == EPI_RES) {
        const int col0 = pn * BM + wc * 32 + 4 * fq;
#pragma unroll
        for (int ai = 0; ai < 2; ++ai) {
            u32x2 xr[4][2][2];
#pragma unroll
            for (int m = 0; m < 4; ++m)
#pragma unroll
                for (int bj = 0; bj < 2; ++bj)
#pragma unroll
                    for (int n = 0; n < 2; ++n) xr[m][bj][n] = *(const u32x2*)(e.b1 + (size_t)(row0 + ai * HALF + m * 16) * 1024 + col0 + bj * HALF + n * 16);
#pragma unroll
            for (int m = 0; m < 4; ++m)
#pragma unroll
                for (int bj = 0; bj < 2; ++bj)
#pragma unroll
                    for (int n = 0; n < 2; ++n) {
                        const u32x2 xw = xr[m][bj][n]; const f32x4 x = (f32x4){bflo(xw.x), bfhi(xw.x), bflo(xw.y), bfhi(xw.y)};
                        const f32x4 t = x * e.s0 + acc[ai][bj][m][n] * e.s1;
                        u32x2 w; w.x = cvt_pk_bf16(t[0], t[1]); w.y = cvt_pk_bf16(t[2], t[3]);
                        *(u32x2*)(e.b0 + (size_t)(row0 + ai * HALF + m * 16) * 1024 + col0 + bj * HALF + n * 16) = w;
                    }
            asm volatile("" ::: "memory");
        }
    } else if constexpr (MODE == EPI_BF16) {
        const int col0 = pn * BM + wc * 32 + 8 * fq;
#pragma unroll
        for (int ai = 0; ai < 2; ++ai)
#pragma unroll
            for (int m = 0; m < 4; ++m) {
                bf16_t* rowp = e.b0 + (size_t)(row0 + ai * HALF + m * 16) * e.ldc + col0;
#pragma unroll
                for (int bj = 0; bj < 2; ++bj) {
                    f32x4 v0 = acc[ai][bj][m][0], v1 = acc[ai][bj][m][1];
                    if (e.flag) {
#pragma unroll
                        for (int j = 0; j < 4; ++j) { v0[j] = geluf(v0[j]); v1[j] = geluf(v1[j]); }
                    }
                    u32x4 w; w.x = cvt_pk_bf16(v0[0], v0[1]); w.y = cvt_pk_bf16(v0[2], v0[3]); w.z = cvt_pk_bf16(v1[0], v1[1]); w.w = cvt_pk_bf16(v1[2], v1[3]);
                    *(u32x4*)(rowp + bj * HALF) = w;
                }
            }
    } else if constexpr (MODE == EPI_KV) {
        const int sel = pn >> 2, l = sel >> 1, kv = sel & 1;
        const int e0 = (pn & 3) * BM + wc * 32 + 4 * fq;
        float* ob = e.f0 + (kv ? O_MV : O_MK) + (size_t)(l * 8 + pm) * 256 * 1024;
        bf16_t* kb = e.b0 + (size_t)(l * 8 + pm) * 256 * 1024;
        bf16_t* vt = e.b1 + (size_t)(l * 8 + pm) * 1024 * 256;
#pragma unroll
        for (int ai = 0; ai < 2; ++ai)
#pragma unroll
            for (int m = 0; m < 4; ++m) {
                const int mm = wr * 64 + fr + ai * HALF + m * 16;
#pragma unroll
                for (int bj = 0; bj < 2; ++bj)
#pragma unroll
                    for (int n = 0; n < 2; ++n) {
                        const int ee = e0 + bj * HALF + n * 16;
                        const f32x4 v = acc[ai][bj][m][n];
                        __builtin_nontemporal_store(v, (f32x4*)(ob + (size_t)mm * 1024 + ee));
                        if (kv == 0) { u32x2 w; w.x = cvt_pk_bf16(v[0], v[1]); w.y = cvt_pk_bf16(v[2], v[3]); *(u32x2*)(kb + (size_t)mm * 1024 + ee) = w; }
                        else {
#pragma unroll
                            for (int j = 0; j < 4; ++j) vt[(size_t)(ee + j) * 256 + mm] = f2bf(v[j]);
                        }
                    }
            }
    } else if constexpr (MODE == EPI_SCORES) {
        const int col0 = pn * BM + wc * 32 + 8 * fq;
#pragma unroll
        for (int ai = 0; ai < 2; ++ai)
#pragma unroll
            for (int m = 0; m < 4; ++m) {
                const size_t row = (size_t)(row0 + ai * HALF + m * 16);
                float s = 0.f;
#pragma unroll
                for (int bj = 0; bj < 2; ++bj) {
                    float p[8];
#pragma unroll
                    for (int n = 0; n < 2; ++n)
#pragma unroll
                        for (int j = 0; j < 4; ++j) { p[n * 4 + j] = __builtin_amdgcn_exp2f(acc[ai][bj][m][n][j] * (0.0625f * 1.4426950408889634f)); s += p[n * 4 + j]; }
                    u32x4 w; w.x = cvt_pk_bf16(p[0], p[1]); w.y = cvt_pk_bf16(p[2], p[3]); w.z = cvt_pk_bf16(p[4], p[5]); w.w = cvt_pk_bf16(p[6], p[7]);
                    *(u32x4*)(e.b0 + row * 1024 + col0 + bj * HALF) = w;
                }
                s += __shfl_xor(s, 16); s += __shfl_xor(s, 32);
                if (fq == 0) atomicAdd(e.f0 + row * 4 + pn, s);
            }
    } else if constexpr (MODE == EPI_PART) {
        float* base = e.f0 + (size_t)(pn >> 2) * 256 * 1024 + (size_t)(wr * 64 + fr) * 1024 + (pn & 3) * BM + wc * 32 + 4 * fq;
#pragma unroll
        for (int ai = 0; ai < 2; ++ai)
#pragma unroll
            for (int m = 0; m < 4; ++m)
#pragma unroll
                for (int bj = 0; bj < 2; ++bj)
#pragma unroll
                    for (int n = 0; n < 2; ++n) *(f32x4*)(base + (size_t)(ai * HALF + m * 16) * 1024 + bj * HALF + n * 16) = acc[ai][bj][m][n];
    } else if constexpr (MODE == EPI_PV) {
        const int col0 = pn * BM + wc * 32 + 8 * fq;
        float rs[2][4];
#pragma unroll
        for (int ai = 0; ai < 2; ++ai)
#pragma unroll
            for (int m = 0; m < 4; ++m) rs[ai][m] = e.f1[(size_t)(row0 + ai * HALF + m * 16) * 4 + pn];
#pragma unroll
        for (int ai = 0; ai < 2; ++ai)
#pragma unroll
            for (int m = 0; m < 4; ++m) {
                const size_t row = (size_t)(row0 + ai * HALF + m * 16);
                const float inv = 1.f / rs[ai][m];
#pragma unroll
                for (int bj = 0; bj < 2; ++bj) {
                    const f32x4 v0 = acc[ai][bj][m][0] * inv, v1 = acc[ai][bj][m][1] * inv;
                    u32x4 w; w.x = cvt_pk_bf16(v0[0], v0[1]); w.y = cvt_pk_bf16(v0[2], v0[3]); w.z = cvt_pk_bf16(v1[0], v1[1]); w.w = cvt_pk_bf16(v1[2], v1[3]);
                    *(u32x4*)(e.b0 + row * 1024 + col0 + bj * HALF) = w;
                }
            }
    }
}

template <bool PERMUTED>
__device__ __forceinline__ void epilogue_part(const f32x4 (&acc)[2][2][4][2], int pn, int wr, int wc, int fr, int fq, float* part) {
    float* base = part + (size_t)(pn >> 2) * 256 * 1024 + (size_t)(wr * 64 + fr) * 1024 + (pn & 3) * BM + wc * 32 + (PERMUTED ? 8 * fq : 4 * fq);
#pragma unroll
    for (int ai = 0; ai < 2; ++ai)
#pragma unroll
        for (int m = 0; m < 4; ++m)
#pragma unroll
            for (int bj = 0; bj < 2; ++bj)
#pragma unroll
                for (int n = 0; n < 2; ++n) *(f32x4*)(base + (size_t)(ai * HALF + m * 16) * 1024 + bj * HALF + (PERMUTED ? 4 * n : 16 * n)) = acc[ai][bj][m][n];
}

template <int MODE>
__device__ __forceinline__ void gemm_phase(LAS unsigned char* lds, const GemmP g, const EpiA e) {
    constexpr bool PERM = (MODE == EPI_SWIGLU || MODE == EPI_BF16 || MODE == EPI_SCORES || MODE == EPI_PV);
    int tid_ = threadIdx.x; asm volatile("" : "+v"(tid_));
    const int tid = tid_, wid = __builtin_amdgcn_readfirstlane(tid >> 6), lane = tid & 63, wr = wid >> 2, wc = wid & 3, fr = lane & 15, fq = lane >> 4;
    const int nt = g.nt;
    unsigned voffA[2], voffB[2];
#pragma unroll
    for (int i = 0; i < 2; ++i) { int R, C; stage_rc(tid * 16 + i * 8192, R, C); const int Rb = PERM ? ((R & ~31) + perm32(R & 31)) : R;
        voffA[i] = (unsigned)(R * g.lda + C) * 2u; voffB[i] = (unsigned)(Rb * g.ldb + C) * 2u; }
    const size_t kstep = (size_t)(BK * 2);
    const size_t hstepA = (size_t)HALF * g.lda * 2, hstepB = (size_t)HALF * g.ldb * 2;
    const unsigned ldsw = (unsigned)wid * 1024u;
    const int aoff = lds_byte(wr * 64 + fr, fq * 8), boff = lds_byte(wc * 32 + fr, fq * 8);
#define PG8_SA(b, h) (((b) * 2 + (h)) * HTB)
#define PG8_SB(b, h) ((4 + (b) * 2 + (h)) * HTB)
#define PG8_STAGE(bufoff, gbase, voff) do { _Pragma("unroll") for (int _i = 0; _i < 2; ++_i) \
        __builtin_amdgcn_global_load_lds((const unsigned*)((const char*)(gbase) + (voff)[_i]), (LAS unsigned*)(lds + (bufoff) + ldsw + _i * 8192), 16, 0, 0); } while (0)
#define PG8_LDA(dst, b, h) do { _Pragma("unroll") for (int m = 0; m < 4; ++m) _Pragma("unroll") for (int k = 0; k < 2; ++k) dst[m][k] = *(const LAS bf16x8*)(lds + PG8_SA(b, h) + aoff + m * 2048 + k * 1024); } while (0)
#define PG8_LDB(dst, b, h) do { _Pragma("unroll") for (int n = 0; n < 2; ++n) _Pragma("unroll") for (int k = 0; k < 2; ++k) dst[n][k] = *(const LAS bf16x8*)(lds + PG8_SB(b, h) + boff + n * 2048 + k * 1024); } while (0)
#define PG8_MMA(ai, bj, At, Bt) do { __builtin_amdgcn_s_setprio(1); _Pragma("unroll") for (int m = 0; m < 4; ++m) _Pragma("unroll") for (int n = 0; n < 2; ++n) _Pragma("unroll") for (int k = 0; k < 2; ++k) \
        acc[ai][bj][m][n] = __builtin_amdgcn_mfma_f32_16x16x32_bf16(Bt[n][k], At[m][k], acc[ai][bj][m][n], 0, 0, 0); __builtin_amdgcn_s_setprio(0); } while (0)
#define PG8_WAIT_V(n) asm volatile("s_waitcnt vmcnt(" #n ")" ::: "memory")
#define PG8_WAIT_L(n) asm volatile("s_waitcnt lgkmcnt(" #n ")" ::: "memory")
#define PG8_BAR __builtin_amdgcn_s_barrier()
#define PG8_SCHED __builtin_amdgcn_sched_barrier(0)
    int cpm, cpn, npm = 0, npn = 0, ui = 0; bool csp = false, nsp = false;
    auto get_unit = [&](int i, int& pm, int& pn, bool& sp) -> bool {
        if (unit_next(i, g.nM, g.nN, pm, pn, g.rev)) { sp = false; return true; }
        if (g.nsplit > 0) {
            const int G_ = gridDim.x, bx_ = blockIdx.x, nwg_ = g.nM * g.nN;
            const int nmain = bx_ < nwg_ ? (nwg_ - bx_ + G_ - 1) / G_ : 0;
            const int L = (i - nmain) * G_ + (G_ - 1 - bx_);
            if (i >= nmain && L < 4 * g.nsplit) { pm = 64; pn = L; sp = true; return true; }
        }
        return false;
    };
    auto base_a = [&](int pm, int pn, bool sp) -> const char* {
        return sp ? g.A + (size_t)64 * g.a_pm + (size_t)(pn >> 2) * 512 : g.A + (size_t)pm * g.a_pm + (size_t)(pn & g.pn_mask) * g.a_pn + (size_t)(pn >> g.pn_shift) * g.a_ks; };
    auto base_b = [&](int pm, int pn, bool sp) -> const char* {
        return sp ? g.B + (size_t)(pn & 3) * g.b_pn + (size_t)(pn >> 2) * 512 : g.B + (size_t)(pm >> 3) * g.b_pb + (size_t)(pn & g.pn_mask) * g.b_pn + (size_t)(pn >> g.pn_shift) * g.b_ks; };
    if (!get_unit(0, cpm, cpn, csp)) return;
    f32x4 acc[2][2][4][2];
#pragma unroll
    for (int a = 0; a < 2; ++a)
#pragma unroll
        for (int b = 0; b < 2; ++b)
#pragma unroll
            for (int m = 0; m < 4; ++m)
#pragma unroll
                for (int n = 0; n < 2; ++n) acc[a][b][m][n] = (f32x4){0.f, 0.f, 0.f, 0.f};
    bf16x8 At[4][2], B0[2][2], B1[2][2];
    const char* cA = base_a(cpm, cpn, csp);
    const char* cB = base_b(cpm, cpn, csp);
    PG8_STAGE(PG8_SB(0, 0), cB, voffB); PG8_STAGE(PG8_SA(0, 0), cA, voffA); PG8_STAGE(PG8_SB(0, 1), cB + hstepB, voffB); PG8_STAGE(PG8_SA(0, 1), cA + hstepA, voffA);
    if (wr == 1) PG8_BAR;
    PG8_WAIT_V(4); PG8_BAR;
    PG8_STAGE(PG8_SB(1, 0), cB + kstep, voffB); PG8_STAGE(PG8_SA(1, 0), cA + kstep, voffA); PG8_STAGE(PG8_SB(1, 1), cB + hstepB + kstep, voffB);
    PG8_WAIT_V(6); PG8_BAR;
    for (;;) {
        const bool has_next = get_unit(ui + 1, npm, npn, nsp);
        const char* nA = has_next ? base_a(npm, npn, nsp) : cA;
        const char* nB = has_next ? base_b(npm, npn, nsp) : cB;
        const int cnt = csp ? 4 : nt;
        for (int t = 0; t < cnt; t += 2) {
            const bool last = (t == cnt - 2);
            const char* a1 = cA + (size_t)(t + 1) * kstep;
            const char* a2 = last ? nA : cA + (size_t)(t + 2) * kstep; const char* b2 = last ? nB : cB + (size_t)(t + 2) * kstep;
            const char* a3 = a2 + kstep; const char* b3 = b2 + kstep;
            PG8_LDB(B0, 0, 0); PG8_SCHED; PG8_LDA(At, 0, 0); PG8_STAGE(PG8_SA(1, 1), a1 + hstepA, voffA);
            PG8_WAIT_L(8); PG8_BAR; PG8_WAIT_L(0); PG8_MMA(0, 0, At, B0); PG8_BAR; PG8_SCHED;
            PG8_LDB(B1, 0, 1); PG8_STAGE(PG8_SB(0, 0), b2, voffB);
            PG8_BAR; PG8_WAIT_L(0); PG8_MMA(0, 1, At, B1); PG8_BAR;
            PG8_LDA(At, 0, 1); PG8_STAGE(PG8_SA(0, 0), a2, voffA);
            PG8_BAR; PG8_WAIT_L(0); PG8_MMA(1, 0, At, B0); PG8_BAR; PG8_SCHED;
            PG8_STAGE(PG8_SB(0, 1), b2 + hstepB, voffB);
            PG8_WAIT_V(6); PG8_BAR; PG8_MMA(1, 1, At, B1); PG8_BAR;
            PG8_LDB(B0, 1, 0); PG8_SCHED; PG8_LDA(At, 1, 0); PG8_STAGE(PG8_SA(0, 1), a2 + hstepA, voffA);
            PG8_WAIT_L(8); PG8_BAR; PG8_WAIT_L(0); PG8_MMA(0, 0, At, B0); PG8_BAR; PG8_SCHED;
            PG8_LDB(B1, 1, 1); PG8_STAGE(PG8_SB(1, 0), b3, voffB);
            PG8_BAR; PG8_WAIT_L(0); PG8_MMA(0, 1, At, B1); PG8_BAR;
            PG8_LDA(At, 1, 1); PG8_STAGE(PG8_SA(1, 0), a3, voffA);
            PG8_BAR; PG8_WAIT_L(0); PG8_MMA(1, 0, At, B0); PG8_BAR; PG8_SCHED;
            PG8_STAGE(PG8_SB(1, 1), b3 + hstepB, voffB);
            PG8_WAIT_V(6); PG8_BAR; PG8_MMA(1, 1, At, B1); PG8_BAR;
        }
        if (csp) epilogue_part<PERM>(acc, cpn, wr, wc, fr, fq, e.f0); else epilogue<MODE>(acc, cpm, cpn, wr, wc, fr, fq, e);
        if (!has_next) break;
#pragma unroll
        for (int a = 0; a < 2; ++a)
#pragma unroll
            for (int b = 0; b < 2; ++b)
#pragma unroll
                for (int m = 0; m < 4; ++m)
#pragma unroll
                    for (int n = 0; n < 2; ++n) acc[a][b][m][n] = (f32x4){0.f, 0.f, 0.f, 0.f};
        cpm = npm; cpn = npn; csp = nsp; cA = nA; cB = nB; ++ui;
    }
    PG8_WAIT_V(0);
    if (wr == 0) PG8_BAR;
    PG8_BAR;
#undef PG8_SA
#undef PG8_SB
#undef PG8_STAGE
#undef PG8_LDA
#undef PG8_LDB
#undef PG8_MMA
#undef PG8_WAIT_V
#undef PG8_WAIT_L
#undef PG8_BAR
#undef PG8_SCHED
}

__device__ __forceinline__ GemmP mk_gemm(const void* A, int lda, const void* B, int ldb, int K, int nM, int nN) {
    GemmP g; g.A = (const char*)A; g.B = (const char*)B; g.a_pm = (long)BM * lda * 2; g.a_pn = 0; g.b_pb = 0; g.b_pn = (long)BM * ldb * 2;
    g.lda = lda; g.ldb = ldb; g.nt = K / BK; g.nM = nM; g.nN = nN; g.a_ks = 0; g.b_ks = 0; g.pn_mask = 0x7fffffff; g.pn_shift = 30; g.nsplit = 0; g.rev = 0; return g;
}
__device__ __forceinline__ GemmP mk_gemm_split(const bf16_t* A, int lda, const bf16_t* B, int ldb, int K) {
    GemmP g = mk_gemm(A + (size_t)MP * lda, lda, B, ldb, 256, 1, 4 * (K / 256));
    g.a_pn = 0; g.a_ks = 512; g.b_ks = 512; g.pn_mask = 3; g.pn_shift = 2; return g;
}

__device__ __forceinline__ void tr_item(const float* src, int sld, bf16_t* dst, int dld, int nvalid, LAS float* scr, int lane) {
    {
        const int n4 = (lane & 7) * 4; f32x4 v[8];
#pragma unroll
        for (int i = 0; i < 8; ++i) { const int kk = 8 * i + (lane >> 3); v[i] = (n4 < nvalid) ? __builtin_nontemporal_load((const f32x4*)(src + (size_t)kk * sld + n4)) : (f32x4){0.f, 0.f, 0.f, 0.f}; }
#pragma unroll
        for (int i = 0; i < 8; ++i) { const int kk = 8 * i + (lane >> 3); LAS float* d = scr + kk * 33 + n4; d[0] = v[i][0]; d[1] = v[i][1]; d[2] = v[i][2]; d[3] = v[i][3]; }
    }
    LDS_WAIT(); asm volatile("" ::: "memory");
    const int c = lane & 7;
#pragma unroll
    for (int j = 0; j < 4; ++j) { const int n = (lane >> 3) + 8 * j; const LAS float* s = scr + (8 * c) * 33 + n;
        u32x4 o; o.x = cvt_pk_bf16(s[0 * 33], s[1 * 33]); o.y = cvt_pk_bf16(s[2 * 33], s[3 * 33]); o.z = cvt_pk_bf16(s[4 * 33], s[5 * 33]); o.w = cvt_pk_bf16(s[6 * 33], s[7 * 33]);
        *(u32x4*)(dst + (size_t)n * dld + 8 * c) = o; }
    LDS_WAIT(); asm volatile("" ::: "memory");
}

__device__ __noinline__ void prep_phase(ArgsP a, LAS unsigned char* lds) {
    const int tid = threadIdx.x, lane = tid & 63, wave = tid >> 6;
    unsigned char* ws = a->ws;
    LAS float* scr = (LAS float*)(lds + wave * 8704);
    const int gw = blockIdx.x * 8 + wave, NGW = gridDim.x * 8;
    bf16_t* Wgu = (bf16_t*)(ws + WS_WGU); bf16_t* Wdn = (bf16_t*)(ws + WS_WDN);
    constexpr int I_FFN = 4 * 4224, I_SQ = 512;
    constexpr int NITEMS = I_FFN + 8 * I_SQ + 1024 + 512 + 16 + 512 + 1024 + 512;
#pragma unroll 1
    for (int it = gw; it < NITEMS; it += NGW) {
        int r = it;
        const float* src; bf16_t* dst; int sld, dld, nvalid = 32;
        bf16_t* Wab = (bf16_t*)(ws + WS_WABIN);
        if (r < I_FFN) {
            const int ls = r / 4224; r %= 4224; const int which = r / 1408; r %= 1408;
            if (which < 2) { const int kb = r / 88, nb = r % 88, n0 = nb * 32, k0 = kb * 64;
                src = a->in[which == 0 ? 10 : 11] + (size_t)ls * 1024 * 2816 + (size_t)k0 * 2816 + n0; sld = 2816;
                const int drow = (n0 / 128) * 256 + which * 128 + (n0 % 128);
                dst = Wgu + ((size_t)ls * 5632 + drow) * 1024 + k0; dld = 1024;
            } else { const int kb = r / 32, nb = r % 32, n0 = nb * 32, k0 = kb * 64;
                src = a->in[12] + (size_t)ls * 2816 * 1024 + (size_t)k0 * 1024 + n0; sld = 1024;
                dst = Wdn + ((size_t)ls * 1024 + n0) * 2816 + k0; dld = 2816; }
        } else if ((r -= I_FFN) < 8 * I_SQ) {
            const int mat = r / 1024; r %= 1024; const int l = r / 512; r %= 512;
            const int kb = r / 32, nb = r % 32, n0 = nb * 32, k0 = kb * 64;
            src = a->in[13 + mat] + (size_t)l * 1024 * 1024 + (size_t)k0 * 1024 + n0; sld = 1024; dld = 1024;
            if (mat == 0) dst = (bf16_t*)(ws + WS_WQ) + ((size_t)l * 1024 + n0) * 1024 + k0;
            else if (mat == 3) dst = (bf16_t*)(ws + WS_WO) + ((size_t)l * 1024 + n0) * 1024 + k0;
            else dst = (bf16_t*)(ws + WS_WKV) + ((size_t)(l * 2 + (mat - 1)) * 1024 + n0) * 1024 + k0;
        } else if ((r -= 8 * I_SQ) < 1024) { const int kb = r / 64, nb = r % 64, n0 = nb * 32, k0 = kb * 64;
            src = a->in[17] + (size_t)k0 * 3080 + n0; sld = 3080; dst = Wab + (size_t)n0 * 1024 + k0; dld = 1024;
        } else if ((r -= 1024) < 512) { const int kb = r / 32, nb = r % 32, n0 = nb * 32, k0 = kb * 64;
            src = a->in[17] + (size_t)k0 * 3080 + 2056 + n0; sld = 3080; dst = Wab + (size_t)(2048 + n0) * 1024 + k0; dld = 1024;
        } else if ((r -= 512) < 16) { const int k0 = r * 64;
            src = a->in[17] + (size_t)k0 * 3080 + 2048; sld = 3080; dst = Wab + (size_t)3072 * 1024 + k0; dld = 1024; nvalid = 8;
        } else if ((r -= 16) < 512) { const int kb = r / 32, nb = r % 32, n0 = nb * 32, k0 = kb * 64;
            src = a->in[26] + (size_t)k0 * 1024 + n0; sld = 1024; dst = (bf16_t*)(ws + WS_WABOUT) + (size_t)n0 * 1024 + k0; dld = 1024;
        } else if ((r -= 512) < 1024) { const int kb = r / 64, nb = r % 64, n0 = nb * 32, k0 = kb * 64;
            src = a->in[27] + (size_t)k0 * 2048 + n0; sld = 2048; dst = (bf16_t*)(ws + WS_WGMIN) + (size_t)n0 * 1024 + k0; dld = 1024;
        } else { r -= 1024; const int kb = r / 32, nb = r % 32, n0 = nb * 32, k0 = kb * 64;
            src = a->in[32] + (size_t)k0 * 1024 + n0; sld = 1024; dst = (bf16_t*)(ws + WS_WGMOUT) + (size_t)n0 * 1024 + k0; dld = 1024; }
        tr_item(src, sld, dst, dld, nvalid, scr, lane);
    }
    bf16_t* XB = (bf16_t*)(ws + WS_XB); bf16_t* MEMB = (bf16_t*)(ws + WS_MEMB);
#pragma unroll 1
    for (int row = gw; row < MT + 2048; row += NGW) {
        if (row < MT) {
            const float* src = row < MP ? a->in[0] + (size_t)row * 1024 : a->in[1] + (size_t)(row - MP) * 1024;
#pragma unroll
            for (int j = 0; j < 4; ++j) { f32x4 v = (f32x4){0.f, 0.f, 0.f, 0.f}; if (row < MV) v = __builtin_nontemporal_load((const f32x4*)(src + (lane + 64 * j) * 4));
                u32x2 w; w.x = cvt_pk_bf16(v[0], v[1]); w.y = cvt_pk_bf16(v[2], v[3]); *(u32x2*)(XB + (size_t)row * 1024 + (lane + 64 * j) * 4) = w; }
        } else {
            const int mr = row - MT; const float* src = a->in[2] + (size_t)mr * 1024;
#pragma unroll
            for (int j = 0; j < 4; ++j) { const f32x4 v = __builtin_nontemporal_load((const f32x4*)(src + (lane + 64 * j) * 4));
                u32x2 w; w.x = cvt_pk_bf16(v[0], v[1]); w.y = cvt_pk_bf16(v[2], v[3]); *(u32x2*)(MEMB + (size_t)mr * 1024 + (lane + 64 * j) * 4) = w; }
        }
    }
    const size_t gt = (size_t)blockIdx.x * 512 + tid, NGT = (size_t)gridDim.x * 512;
    { u32x4* z = (u32x4*)((bf16_t*)(ws + WS_WABIN) + (size_t)3104 * 1024); const size_t n = (size_t)(ABN - 3104) * 1024 * 2 / 16;
      for (size_t i = gt; i < n; i += NGT) z[i] = (u32x4){0u, 0u, 0u, 0u}; }
    { u32x4* z = (u32x4*)(ws + WS_ROWSUM); const size_t n = (size_t)2 * MP * 4 * 4 / 16;
      for (size_t i = gt; i < n; i += NGT) z[i] = (u32x4){0u, 0u, 0u, 0u}; }
    { bf16_t* o = (bf16_t*)(ws + WS_WGMS);
      for (size_t i = gt; i < (size_t)4 * 128 * 128; i += NGT) { const int ii = (int)((i >> 7) & 127), jj = (int)(i & 127); o[i] = f2bf(jj <= ii ? a->in[30][i] : 0.f); } }
}

__device__ __forceinline__ void ln_row_finish(f32x4 (&v)[4], const f32x4 (&gv)[4], const f32x4 (&bv)[4], bf16_t* XB, float* yout, size_t row, int lane) {
    float s = 0.f;
#pragma unroll
    for (int j = 0; j < 4; ++j) s += (v[j][0] + v[j][1]) + (v[j][2] + v[j][3]);
    const float mean = wave_sum(s) * (1.f / 1024.f); float q = 0.f;
#pragma unroll
    for (int j = 0; j < 4; ++j) { v[j] = v[j] - mean; q += (v[j][0] * v[j][0] + v[j][1] * v[j][1]) + (v[j][2] * v[j][2] + v[j][3] * v[j][3]); }
    const float rstd = rsqrtf(wave_sum(q) * (1.f / 1024.f) + LN_EPS);
#pragma unroll
    for (int j = 0; j < 4; ++j) { const f32x4 o = v[j] * rstd * gv[j] + bv[j];
        u32x2 w; w.x = cvt_pk_bf16(o[0], o[1]); w.y = cvt_pk_bf16(o[2], o[3]); *(u32x2*)(XB + row * 1024 + (lane + 64 * j) * 4) = w;
        if (yout) __builtin_nontemporal_store(o, (f32x4*)(yout + row * 1024 + (lane + 64 * j) * 4)); }
}
__device__ __forceinline__ f32x4 ld_bf4(const bf16_t* p) { const u32x2 w = __builtin_nontemporal_load((const u32x2*)p); return (f32x4){bflo(w.x), bfhi(w.x), bflo(w.y), bfhi(w.y)}; }
__device__ __noinline__ void ln_phase(ArgsP a, int l, int idx, bool final_out, int nsplit, float scale) {
    const int lane = threadIdx.x & 63, wave = threadIdx.x >> 6;
    const int gw = blockIdx.x * 8 + wave, NGW = gridDim.x * 8;
    const bf16_t* T = (const bf16_t*)(a->ws + WS_T); bf16_t* XB = (bf16_t*)(a->ws + WS_XB);
    float* yout = final_out ? a->out + O_Y : nullptr;
    const float* g = a->in[8] + (size_t)(l * 4 + idx) * 1024; const float* b = a->in[9] + (size_t)(l * 4 + idx) * 1024;
    f32x4 gv[4], bv[4];
#pragma unroll
    for (int j = 0; j < 4; ++j) { gv[j] = *(const f32x4*)(g + (lane + 64 * j) * 4); bv[j] = *(const f32x4*)(b + (lane + 64 * j) * 4); }
    for (int row = MP + gw; row < MV; row += NGW) {
        f32x4 v[4];
#pragma unroll
        for (int j = 0; j < 4; ++j) {
            f32x4 p = (f32x4){0.f, 0.f, 0.f, 0.f};
            for (int ks = 0; ks < nsplit; ++ks) p += *(const f32x4*)((const float*)(a->ws + WS_PART) + ((size_t)ks * 256 + (row - MP)) * 1024 + (lane + 64 * j) * 4);
            v[j] = ld_bf4(XB + (size_t)row * 1024 + (lane + 64 * j) * 4) * ALPHA + p * scale;
        }
        ln_row_finish(v, gv, bv, XB, yout, (size_t)row, lane);
    }
    for (int row = gw; row < MP; row += 2 * NGW) {
        const int row2 = row + NGW; const bool has2 = row2 < MP;
        f32x4 v0[4], v1[4];
#pragma unroll
        for (int j = 0; j < 4; ++j) v0[j] = ld_bf4(T + (size_t)row * 1024 + (lane + 64 * j) * 4);
#pragma unroll
        for (int j = 0; j < 4; ++j) v1[j] = has2 ? ld_bf4(T + (size_t)row2 * 1024 + (lane + 64 * j) * 4) : (f32x4){0.f, 0.f, 0.f, 0.f};
        ln_row_finish(v0, gv, bv, XB, yout, (size_t)row, lane);
        if (has2) ln_row_finish(v1, gv, bv, XB, yout, (size_t)row2, lane);
    }
}

constexpr int GST = 132;
__device__ __noinline__ void gdn_prep_item(ArgsP a, LAS unsigned char* lds, int item) {
    const int tid = threadIdx.x, lane = tid & 63, wave = tid >> 6;
    const int bh = item >> 5, n = item & 31, b = bh >> 2, h = bh & 3;
    const bf16_t* PROJ = (const bf16_t*)(a->ws + WS_WIDE);
    LAS float* qs = (LAS float*)lds; LAS float* ks = qs + 64 * GST; LAS float* vs = ks + 64 * GST; LAS float* Ms = vs + 64 * GST;
    LAS float* gc = Ms + 64 * 64; LAS float* bs = gc + 64; LAS float* eg = bs + 64;
    const size_t rowbase = (size_t)b * SEQ + (size_t)n * 64;
    {
        const int c = tid & 127, tq = tid >> 7;
#pragma unroll
        for (int seg = 0; seg < 3; ++seg) {
            const int col = seg * 512 + h * 128 + c;
            const float w0 = a->in[18][col], w1 = a->in[18][1536 + col], w2 = a->in[18][2 * 1536 + col], w3 = a->in[18][3 * 1536 + col];
            LAS float* dst = seg == 0 ? qs : (seg == 1 ? ks : vs);
            const int t0 = tq * 16;
            float x0 = 0.f, x1 = 0.f, x2 = 0.f;
            {
                const long tt = (long)n * 64 + t0;
                if (tt - 3 >= 0) x0 = bf2f(PROJ[(rowbase + t0 - 3) * ABN + col]);
                if (tt - 2 >= 0) x1 = bf2f(PROJ[(rowbase + t0 - 2) * ABN + col]);
                if (tt - 1 >= 0) x2 = bf2f(PROJ[(rowbase + t0 - 1) * ABN + col]);
            }
            bf16_t xr[16];
#pragma unroll
            for (int t = 0; t < 16; ++t) xr[t] = PROJ[(rowbase + t0 + t) * ABN + col];
#pragma unroll
            for (int t = 0; t < 16; ++t) {
                const float x3 = bf2f(xr[t]);
                const float y = w0 * x0 + w1 * x1 + w2 * x2 + w3 * x3;
                dst[(t0 + t) * GST + c] = siluf(y);
                x0 = x1; x1 = x2; x2 = x3;
            }
        }
        if (tid < 64) {
            const float braw = bf2f(PROJ[(rowbase + tid) * ABN + 3072 + h]);
            const float araw = bf2f(PROJ[(rowbase + tid) * ABN + 3076 + h]);
            const float xx = araw + a->in[20][h];
            const float sp = xx > 20.f ? xx : log1pf(__expf(xx));
            float gval = -__expf(a->in[19][h]) * sp;
            bs[tid] = sigmf(braw);
#pragma unroll
            for (int o = 1; o < 64; o <<= 1) { const float nb_ = __shfl_up(gval, o); if (lane >= o) gval += nb_; }
            gc[tid] = gval; eg[tid] = __expf(gval);
        }
    }
    __syncthreads();
    {
        LAS float* base = (wave < 4 ? qs : ks) + ((wave & 3) * 16) * GST;
        float x0[16], x1[16], ss[16];
#pragma unroll
        for (int r = 0; r < 16; ++r) { x0[r] = base[r * GST + lane]; x1[r] = base[r * GST + lane + 64]; ss[r] = x0[r] * x0[r] + x1[r] * x1[r]; }
#pragma unroll
        for (int o = 1; o < 64; o <<= 1)
#pragma unroll
            for (int r = 0; r < 16; ++r) ss[r] += __shfl_xor(ss[r], o);
        const float qsc = wave < 4 ? 0.08838834764831845f : 1.f;
#pragma unroll
        for (int r = 0; r < 16; ++r) { const float sc = rsqrtf(ss[r] + 1e-6f) * qsc; base[r * GST + lane] = x0[r] * sc; base[r * GST + lane + 64] = x1[r] * sc; }
    }
    __syncthreads();
    {
        const int i = tid >> 3, jg = tid & 7;
        float aM[8], aQ[8];
#pragma unroll
        for (int jj = 0; jj < 8; ++jj) { aM[jj] = 0.f; aQ[jj] = 0.f; }
        for (int d = 0; d < 128; d += 4) {
            const f32x4 ki = *(const LAS f32x4*)(ks + i * GST + d), qi = *(const LAS f32x4*)(qs + i * GST + d);
#pragma unroll
            for (int jj = 0; jj < 8; ++jj) {
                const f32x4 kj = *(const LAS f32x4*)(ks + (jg + 8 * jj) * GST + d);
                aM[jj] += (ki[0] * kj[0] + ki[1] * kj[1]) + (ki[2] * kj[2] + ki[3] * kj[3]);
                aQ[jj] += (qi[0] * kj[0] + qi[1] * kj[1]) + (qi[2] * kj[2] + qi[3] * kj[3]);
            }
        }
        const float gi = gc[i], bi = bs[i];
        bf16_t* QK = (bf16_t*)(a->ws + WS_GQK) + (size_t)item * 64 * 64;
#pragma unroll
        for (int jj = 0; jj < 8; ++jj) {
            const int j = jg + 8 * jj;
            const float dec = (j <= i) ? __expf(gi - gc[j]) : 0.f;
            Ms[i * 64 + j] = (j < i) ? bi * aM[jj] * dec : 0.f;
            QK[i * 64 + j] = f2bf(aQ[jj] * dec);
        }
    }
    __syncthreads();
    if (tid < 256) {
        const int c = tid & 127; const bool isw = tid >= 128;
        const LAS float* src = isw ? ks : vs;
        int vz; asm volatile("v_mov_b32 %0, 0" : "=v"(vz));
        const LAS float* Msv = Ms + vz;
        float x[64];
#pragma unroll
        for (int i = 0; i < 64; ++i) x[i] = 0.f;
        float* U = (float*)(a->ws + WS_GU) + (size_t)item * 64 * 128;
        bf16_t* W = (bf16_t*)(a->ws + WS_GW) + (size_t)item * 64 * 128;
#pragma unroll
        for (int i = 0; i < 64; ++i) {
            float acc = src[i * GST + c] * bs[i] * (isw ? eg[i] : 1.f);
#pragma unroll
            for (int j4 = 0; j4 < (i + 3) / 4; ++j4) {
                const f32x4 m = *(const LAS f32x4*)(Msv + i * 64 + j4 * 4);
                acc -= m[0] * x[j4 * 4 + 0]; acc -= m[1] * x[j4 * 4 + 1]; acc -= m[2] * x[j4 * 4 + 2]; acc -= m[3] * x[j4 * 4 + 3];
            }
            x[i] = acc;
            if (isw) W[i * 128 + c] = f2bf(acc); else U[i * 128 + c] = acc;
        }
    } else {
        const int t2 = tid - 256;
        bf16_t* QG = (bf16_t*)(a->ws + WS_GQG) + (size_t)item * 64 * 128;
        bf16_t* KTT = (bf16_t*)(a->ws + WS_GKTT) + (size_t)item * 128 * 64;
        const float glast = gc[63];
        for (int idx = t2; idx < 64 * 128; idx += 256) { const int i = idx >> 7, d = idx & 127; QG[idx] = f2bf(qs[i * GST + d] * eg[i]); }
        for (int idx = t2; idx < 128 * 64; idx += 256) { const int d = idx >> 6, i = idx & 63; KTT[idx] = f2bf(ks[i * GST + d] * __expf(glast - gc[i])); }
        if (t2 == 0) ((float*)(a->ws + WS_GGL))[(size_t)item * 32] = eg[63];
    }
    __syncthreads();
}

__device__ __noinline__ void gdn_sample_item(ArgsP a, LAS unsigned char* lds, int item) {
    const int tid = threadIdx.x, lane = tid & 63, wave = tid >> 6;
    const int b = item >> 2, h = item & 3;
    const bf16_t* PROJ = (const bf16_t*)(a->ws + WS_WIDE) + (size_t)(MP + b) * ABN;
    LAS float* qkv = (LAS float*)lds;
    LAS float* part = qkv + 384;
    LAS float* sc = part + 1024;
    if (tid < 384) {
        const int seg = tid >> 7, c = tid & 127, col = seg * 512 + h * 128 + c;
        const float* buf = a->in[6] + (size_t)b * 3 * 1536;
        const float xn = bf2f(PROJ[col]);
        const float b0 = buf[col], b1 = buf[1536 + col], b2 = buf[2 * 1536 + col];
        const float y = a->in[18][col] * b0 + a->in[18][1536 + col] * b1 + a->in[18][2 * 1536 + col] * b2 + a->in[18][3 * 1536 + col] * xn;
        qkv[tid] = siluf(y);
        float* o = a->out + O_DNC_S + (size_t)b * 3 * 1536;
        o[col] = b1; o[1536 + col] = b2; o[2 * 1536 + col] = xn;
    }
    if (tid == 384) {
        const float braw = bf2f(PROJ[3072 + h]), araw = bf2f(PROJ[3076 + h]);
        const float xx = araw + a->in[20][h]; const float sp = xx > 20.f ? xx : log1pf(__expf(xx));
        sc[1] = sigmf(braw); sc[2] = __expf(-__expf(a->in[19][h]) * sp);
    }
    __syncthreads();
    if (wave < 2) {
        LAS float* p = qkv + wave * 128; const float x0 = p[lane], x1 = p[lane + 64];
        const float ss = wave_sum(x0 * x0 + x1 * x1);
        const float s_ = rsqrtf(ss + 1e-6f) * (wave == 0 ? 0.08838834764831845f : 1.f);
        p[lane] = x0 * s_; p[lane + 64] = x1 * s_;
    }
    __syncthreads();
    if (wave == 0) { const float d = wave_sum(qkv[lane] * qkv[128 + lane] + qkv[lane + 64] * qkv[128 + lane + 64]); if (lane == 0) sc[0] = d; }
    const int e = tid & 127, dq = tid >> 7;
    const float* S0 = a->in[5] + ((size_t)item * 128 + dq * 32) * 128 + e;
    float S[32]; float pk = 0.f, pq = 0.f;
#pragma unroll
    for (int i = 0; i < 32; ++i) { S[i] = __builtin_nontemporal_load(S0 + (size_t)i * 128); }
#pragma unroll
    for (int i = 0; i < 32; ++i) { pk += qkv[128 + dq * 32 + i] * S[i]; pq += qkv[dq * 32 + i] * S[i]; }
    part[dq * 128 + e] = pk; part[512 + dq * 128 + e] = pq;
    __syncthreads();
    const float kS = (part[e] + part[128 + e]) + (part[256 + e] + part[384 + e]);
    const float qS = (part[512 + e] + part[640 + e]) + (part[768 + e] + part[896 + e]);
    const float beta = sc[1], egv = sc[2], qk = sc[0];
    const float vnew = beta * (qkv[256 + e] - egv * kS);
    float* So = a->out + O_DNS_S + ((size_t)item * 128 + dq * 32) * 128 + e;
#pragma unroll
    for (int i = 0; i < 32; ++i) __builtin_nontemporal_store(egv * S[i] + qkv[128 + dq * 32 + i] * vnew, So + (size_t)i * 128);
    if (dq == 0) ((float*)(a->ws + WS_ORAW))[(size_t)(MP + b) * 512 + h * 128 + e] = egv * qS + qk * vnew;
    __syncthreads();
}

__device__ __noinline__ void gdn_scan_item(ArgsP a, LAS unsigned char* lds, int item) {
    const int tid = threadIdx.x, lane = tid & 63, wave = __builtin_amdgcn_readfirstlane(tid >> 6);
    const int bh = item >> 3, sl = item & 7, b = bh >> 2, h = bh & 3, e0 = sl * 16;
    const int ln = lane & 15, kg = lane >> 4;
    LAS bf16_t* ST = (LAS bf16_t*)lds;
    LAS bf16_t* VN = (LAS bf16_t*)(lds + 16 * 136 * 2);
    const float* U = (const float*)(a->ws + WS_GU); const bf16_t* W = (const bf16_t*)(a->ws + WS_GW); const bf16_t* QG = (const bf16_t*)(a->ws + WS_GQG);
    const bf16_t* KTT = (const bf16_t*)(a->ws + WS_GKTT); const bf16_t* QK = (const bf16_t*)(a->ws + WS_GQK); const float* GL = (const float*)(a->ws + WS_GGL);
    float* ORAW = (float*)(a->ws + WS_ORAW);
    f32x4 S = (f32x4){0.f, 0.f, 0.f, 0.f};
    { u32x2 z; z.x = 0u; z.y = 0u; *(LAS u32x2*)(ST + ln * 136 + wave * 16 + kg * 4) = z; }
    __syncthreads();
#ifndef NCH
#define NCH 32
#endif
    for (int n = 0; n < NCH; ++n) {
        const size_t ci = (size_t)bh * 32 + n;
        bf16x8 aw[4], aq[4], aqk[2], akt[2]; f32x4 u = (f32x4){0.f, 0.f, 0.f, 0.f};
#pragma unroll
        for (int k2 = 0; k2 < 2; ++k2) akt[k2] = *(const bf16x8*)(KTT + ci * 8192 + (size_t)(wave * 16 + ln) * 64 + k2 * 32 + kg * 8);
        const float gl = GL[ci * 32];
        f32x4 qsacc = (f32x4){0.f, 0.f, 0.f, 0.f};
        if (wave < 4) {
#pragma unroll
            for (int k4 = 0; k4 < 4; ++k4) { aw[k4] = *(const bf16x8*)(W + ci * 8192 + (size_t)(wave * 16 + ln) * 128 + k4 * 32 + kg * 8);
                                             aq[k4] = *(const bf16x8*)(QG + ci * 8192 + (size_t)(wave * 16 + ln) * 128 + k4 * 32 + kg * 8); }
#pragma unroll
            for (int k2 = 0; k2 < 2; ++k2) aqk[k2] = *(const bf16x8*)(QK + ci * 4096 + (size_t)(wave * 16 + ln) * 64 + k2 * 32 + kg * 8);
#pragma unroll
            for (int j = 0; j < 4; ++j) u[j] = U[ci * 8192 + (size_t)(wave * 16 + kg * 4 + j) * 128 + e0 + ln];
            f32x4 wsacc = (f32x4){0.f, 0.f, 0.f, 0.f};
#pragma unroll
            for (int k4 = 0; k4 < 4; ++k4) {
                const bf16x8 bs_ = *(const LAS bf16x8*)(ST + ln * 136 + k4 * 32 + kg * 8);
                wsacc = __builtin_amdgcn_mfma_f32_16x16x32_bf16(aw[k4], bs_, wsacc, 0, 0, 0);
                qsacc = __builtin_amdgcn_mfma_f32_16x16x32_bf16(aq[k4], bs_, qsacc, 0, 0, 0);
            }
            const f32x4 vn = u - wsacc;
            u32x2 w2; w2.x = cvt_pk_bf16(vn[0], vn[1]); w2.y = cvt_pk_bf16(vn[2], vn[3]);
            *(LAS u32x2*)(VN + ln * 72 + wave * 16 + kg * 4) = w2;
        }
        __syncthreads();
        bf16x8 bv[2];
#pragma unroll
        for (int k2 = 0; k2 < 2; ++k2) bv[k2] = *(const LAS bf16x8*)(VN + ln * 72 + k2 * 32 + kg * 8);
        if (wave < 4) {
#pragma unroll
            for (int k2 = 0; k2 < 2; ++k2) qsacc = __builtin_amdgcn_mfma_f32_16x16x32_bf16(aqk[k2], bv[k2], qsacc, 0, 0, 0);
            const size_t tok = (size_t)b * SEQ + (size_t)n * 64 + wave * 16 + kg * 4;
#pragma unroll
            for (int j = 0; j < 4; ++j) ORAW[(tok + j) * 512 + h * 128 + e0 + ln] = qsacc[j];
        }
        S = S * gl;
#pragma unroll
        for (int k2 = 0; k2 < 2; ++k2) S = __builtin_amdgcn_mfma_f32_16x16x32_bf16(akt[k2], bv[k2], S, 0, 0, 0);
        { u32x2 w2; w2.x = cvt_pk_bf16(S[0], S[1]); w2.y = cvt_pk_bf16(S[2], S[3]); *(LAS u32x2*)(ST + ln * 136 + wave * 16 + kg * 4) = w2; }
        __syncthreads();
    }
    float* So = a->out + O_DNS_P + (size_t)bh * 128 * 128;
#pragma unroll
    for (int j = 0; j < 4; ++j) So[(size_t)(wave * 16 + kg * 4 + j) * 128 + e0 + ln] = S[j];
    __syncthreads();
}

__device__ __noinline__ void gdn_finish_phase(ArgsP a) {
    const int lane = threadIdx.x & 63, wave = threadIdx.x >> 6, sub = lane >> 4, l16 = lane & 15;
    const int gw = blockIdx.x * 8 + wave, NGW = gridDim.x * 8;
    const bf16_t* PROJ = (const bf16_t*)(a->ws + WS_WIDE); const float* ORAW = (const float*)(a->ws + WS_ORAW); bf16_t* OC = (bf16_t*)(a->ws + WS_OC);
    const f32x4 g0 = *(const f32x4*)(a->in[21] + l16 * 8), g1 = *(const f32x4*)(a->in[21] + l16 * 8 + 4);
    for (int p0 = gw * 4; p0 < MV * 4; p0 += NGW * 4) {
        const int p = p0 + sub; const size_t row = (size_t)(p >> 2); const int h = p & 3;
        const f32x4 o0 = __builtin_nontemporal_load((const f32x4*)(ORAW + row * 512 + h * 128 + l16 * 8)), o1 = __builtin_nontemporal_load((const f32x4*)(ORAW + row * 512 + h * 128 + l16 * 8 + 4));
        const u32x4 zw = __builtin_nontemporal_load((const u32x4*)(PROJ + row * ABN + 1536 + h * 128 + l16 * 8));
        float ss = (o0[0] * o0[0] + o0[1] * o0[1]) + (o0[2] * o0[2] + o0[3] * o0[3]) + (o1[0] * o1[0] + o1[1] * o1[1]) + (o1[2] * o1[2] + o1[3] * o1[3]);
        ss += __shfl_xor(ss, 1); ss += __shfl_xor(ss, 2); ss += __shfl_xor(ss, 4); ss += __shfl_xor(ss, 8);
        const float r = rsqrtf(ss * (1.f / 128.f) + 1e-6f);
        u32x4 w;
        w.x = cvt_pk_bf16(o0[0] * r * g0[0] * siluf(bflo(zw.x)), o0[1] * r * g0[1] * siluf(bfhi(zw.x)));
        w.y = cvt_pk_bf16(o0[2] * r * g0[2] * siluf(bflo(zw.y)), o0[3] * r * g0[3] * siluf(bfhi(zw.y)));
        w.z = cvt_pk_bf16(o1[0] * r * g1[0] * siluf(bflo(zw.z)), o1[1] * r * g1[1] * siluf(bfhi(zw.z)));
        w.w = cvt_pk_bf16(o1[2] * r * g1[2] * siluf(bflo(zw.w)), o1[3] * r * g1[3] * siluf(bfhi(zw.w)));
        *(u32x4*)(OC + row * 1024 + h * 128 + l16 * 8) = w;
    }
}

__device__ __noinline__ void conf_item(ArgsP a, LAS unsigned char* lds, int item) {
    const int tid = threadIdx.x, lane = tid & 63, wave = tid >> 6;
    const int b = item >> 6, tt = item & 63, t0 = tt * 32;
    const bf16_t* PROJ = (const bf16_t*)(a->ws + WS_WIDE); bf16_t* OC = (bf16_t*)(a->ws + WS_OC);
    LAS float* G = (LAS float*)lds;
    const int ch = tid;
    for (int r0 = 0; r0 < 64; r0 += 8) {
        bf16_t ga[8], gb[8];
#pragma unroll
        for (int k = 0; k < 8; ++k) { const int r = r0 + k, t = t0 - 30 + r; ga[k] = 0; gb[k] = 0;
            if (r < 62 && t >= 0) { const size_t row = (size_t)b * SEQ + t; ga[k] = PROJ[row * ABN + 2048 + ch]; gb[k] = PROJ[row * ABN + 2560 + ch]; } }
#pragma unroll
        for (int k = 0; k < 8; ++k) { const int r = r0 + k;
            if (r < 62) { const float v = bf2f(ga[k]) * sigmf(bf2f(gb[k]));
                G[r * 512 + ch] = v;
                if (tt == 63 && r >= 32) a->out[O_CCC_P + ((size_t)b * 30 + (r - 32)) * 512 + ch] = v; } }
    }
    if (tt == 63) {
        for (int idx = tid; idx < 3 * 1536; idx += 512) { const int rr = idx / 1536, col = idx % 1536;
            a->out[O_DNC_P + (size_t)b * 3 * 1536 + idx] = bf2f(PROJ[((size_t)b * SEQ + 2045 + rr) * ABN + col]); }
    }
    float w[31];
#pragma unroll
    for (int i = 0; i < 31; ++i) w[i] = a->in[22][i * 512 + ch];
    const float bias = a->in[23][ch];
    __syncthreads();
    float co[32];
#pragma unroll
    for (int t = 0; t < 32; ++t) {
        float acc = bias;
#pragma unroll
        for (int i = 0; i < 31; ++i) acc += w[i] * G[(t + i) * 512 + ch];
        co[t] = acc;
    }
    __syncthreads();
#pragma unroll
    for (int t = 0; t < 32; ++t) G[t * 512 + ch] = co[t];
    __syncthreads();
    for (int t = wave * 4; t < wave * 4 + 4; ++t) {
        float v[8]; float s = 0.f;
#pragma unroll
        for (int k = 0; k < 8; ++k) { v[k] = G[t * 512 + lane + 64 * k]; s += v[k]; }
        const float mean = wave_sum(s) * (1.f / 512.f); float q = 0.f;
#pragma unroll
        for (int k = 0; k < 8; ++k) { v[k] -= mean; q += v[k] * v[k]; }
        const float rstd = rsqrtf(wave_sum(q) * (1.f / 512.f) + LN_EPS);
        const size_t row = (size_t)b * SEQ + t0 + t;
#pragma unroll
        for (int k = 0; k < 8; ++k) { const int c = lane + 64 * k; OC[row * 1024 + 512 + c] = f2bf(siluf(v[k] * rstd * a->in[24][c] + a->in[25][c])); }
    }
    __syncthreads();
}

__device__ __noinline__ void conf_sample_item(ArgsP a, LAS unsigned char* lds, int b) {
    const int tid = threadIdx.x, lane = tid & 63, wave = tid >> 6;
    const bf16_t* PROJ = (const bf16_t*)(a->ws + WS_WIDE) + (size_t)(MP + b) * ABN; bf16_t* OC = (bf16_t*)(a->ws + WS_OC);
    LAS float* red = (LAS float*)lds;
    const int ch = tid;
    const float* buf = a->in[7] + (size_t)b * 30 * 512;
    float* ob = a->out + O_CCC_S + (size_t)b * 30 * 512;
    const float gnew = bf2f(PROJ[2048 + ch]) * sigmf(bf2f(PROJ[2560 + ch]));
    float acc = a->in[23][ch] + a->in[22][30 * 512 + ch] * gnew;
    for (int i = 0; i < 30; ++i) { const float v = buf[i * 512 + ch]; acc += a->in[22][i * 512 + ch] * v; if (i >= 1) ob[(i - 1) * 512 + ch] = v; }
    ob[29 * 512 + ch] = gnew;
    float s = wave_sum(acc); if (lane == 0) red[wave] = s;
    __syncthreads();
    float tot = 0.f;
#pragma unroll
    for (int k = 0; k < 8; ++k) tot += red[k];
    const float mean = tot * (1.f / 512.f); const float dv = acc - mean;
    float q = wave_sum(dv * dv); if (lane == 0) red[8 + wave] = q;
    __syncthreads();
    float tq = 0.f;
#pragma unroll
    for (int k = 0; k < 8; ++k) tq += red[8 + k];
    const float rstd = rsqrtf(tq * (1.f / 512.f) + LN_EPS);
    OC[(size_t)(MP + b) * 1024 + 512 + ch] = f2bf(siluf(dv * rstd * a->in[24][ch] + a->in[25][ch]));
    __syncthreads();
}

__device__ __noinline__ void gm_ln_phase(ArgsP a) {
    const int lane = threadIdx.x & 63, wave = threadIdx.x >> 6;
    const int gw = blockIdx.x * 8 + wave, NGW = gridDim.x * 8;
    const bf16_t* PR = (const bf16_t*)(a->ws + WS_WIDE); bf16_t* VLN = (bf16_t*)(a->ws + WS_QB); bf16_t* OC = (bf16_t*)(a->ws + WS_OC);
    for (int row = gw; row < MV; row += NGW) {
        float v[16]; float s = 0.f;
#pragma unroll
        for (int j = 0; j < 2; ++j) { const u32x4 w = *(const u32x4*)(PR + (size_t)row * 2048 + 1024 + (lane + 64 * j) * 8);
            v[j * 8 + 0] = bflo(w.x); v[j * 8 + 1] = bfhi(w.x); v[j * 8 + 2] = bflo(w.y); v[j * 8 + 3] = bfhi(w.y);
            v[j * 8 + 4] = bflo(w.z); v[j * 8 + 5] = bfhi(w.z); v[j * 8 + 6] = bflo(w.w); v[j * 8 + 7] = bfhi(w.w); }
#pragma unroll
        for (int k = 0; k < 16; ++k) s += v[k];
        const float mean = wave_sum(s) * (1.f / 1024.f); float q = 0.f;
#pragma unroll
        for (int k = 0; k < 16; ++k) { v[k] -= mean; q += v[k] * v[k]; }
        const float rstd = rsqrtf(wave_sum(q) * (1.f / 1024.f) + LN_EPS);
#pragma unroll
        for (int j = 0; j < 2; ++j) {
            const int c0 = (lane + 64 * j) * 8; float o[8];
#pragma unroll
            for (int k = 0; k < 8; ++k) o[k] = v[j * 8 + k] * rstd * a->in[28][c0 + k] + a->in[29][c0 + k];
            u32x4 w; w.x = cvt_pk_bf16(o[0], o[1]); w.y = cvt_pk_bf16(o[2], o[3]); w.z = cvt_pk_bf16(o[4], o[5]); w.w = cvt_pk_bf16(o[6], o[7]);
            *(u32x4*)(VLN + (size_t)row * 1024 + c0) = w;
            if (row >= MP) {
                const int gi = c0 >> 8;
                const float ws0 = a->in[30][(size_t)gi * 128 * 128], bs0 = a->in[31][gi * 128];
                const u32x4 uw = *(const u32x4*)(PR + (size_t)row * 2048 + c0);
                float uu[8] = {bflo(uw.x), bfhi(uw.x), bflo(uw.y), bfhi(uw.y), bflo(uw.z), bfhi(uw.z), bflo(uw.w), bfhi(uw.w)};
                float f[8];
#pragma unroll
                for (int k = 0; k < 8; ++k) { a->out[O_GMV_S + (size_t)(row - MP) * 1024 + c0 + k] = o[k]; f[k] = uu[k] * (ws0 * o[k] + bs0); }
                u32x4 w2; w2.x = cvt_pk_bf16(f[0], f[1]); w2.y = cvt_pk_bf16(f[2], f[3]); w2.z = cvt_pk_bf16(f[4], f[5]); w2.w = cvt_pk_bf16(f[6], f[7]);
                *(u32x4*)(OC + (size_t)row * 1024 + c0) = w2;
            }
        }
    }
}

__device__ __noinline__ void gm_mix_item(ArgsP a, LAS unsigned char* lds, int item) {
    const int tid = threadIdx.x, lane = tid & 63, wave = __builtin_amdgcn_readfirstlane(tid >> 6);
    const int ck = item >> 4, sl = item & 15, gi = sl >> 2, c0 = sl * 64;
    const int ln = lane & 15, kg = lane >> 4;
    const bf16_t* VLN = (const bf16_t*)(a->ws + WS_QB); const bf16_t* PR = (const bf16_t*)(a->ws + WS_WIDE); bf16_t* OC = (bf16_t*)(a->ws + WS_OC);
    const bf16_t* WS_ = (const bf16_t*)(a->ws + WS_WGMS) + (size_t)gi * 128 * 128;
    LAS bf16_t* VTl = (LAS bf16_t*)lds;
    const size_t row0 = (size_t)ck * 128;
#pragma unroll
    for (int i = 0; i < 2; ++i) {
        const int q = tid + 512 * i, j = q >> 3, c8 = q & 7;
        const u32x4 w = *(const u32x4*)(VLN + (row0 + j) * 1024 + c0 + c8 * 8);
        LAS bf16_t* d = VTl + (c8 * 8) * 136 + j;
        d[0 * 136] = (bf16_t)(w.x & 0xffff); d[1 * 136] = (bf16_t)(w.x >> 16); d[2 * 136] = (bf16_t)(w.y & 0xffff); d[3 * 136] = (bf16_t)(w.y >> 16);
        d[4 * 136] = (bf16_t)(w.z & 0xffff); d[5 * 136] = (bf16_t)(w.z >> 16); d[6 * 136] = (bf16_t)(w.w & 0xffff); d[7 * 136] = (bf16_t)(w.w >> 16);
    }
    __syncthreads();
    f32x4 acc[4];
#pragma unroll
    for (int cb = 0; cb < 4; ++cb) acc[cb] = (f32x4){0.f, 0.f, 0.f, 0.f};
    const int ksmax = (wave * 16 + 15) >> 5;
    for (int k4 = 0; k4 <= ksmax; ++k4) {
        const bf16x8 af = *(const bf16x8*)(WS_ + (size_t)(wave * 16 + ln) * 128 + k4 * 32 + kg * 8);
#pragma unroll
        for (int cb = 0; cb < 4; ++cb) {
            const bf16x8 bf_ = *(const LAS bf16x8*)(VTl + (cb * 16 + ln) * 136 + k4 * 32 + kg * 8);
            acc[cb] = __builtin_amdgcn_mfma_f32_16x16x32_bf16(af, bf_, acc[cb], 0, 0, 0);
        }
    }
#pragma unroll
    for (int j = 0; j < 4; ++j) {
        const int i = wave * 16 + kg * 4 + j; const float bsv = a->in[31][gi * 128 + i];
#pragma unroll
        for (int cb = 0; cb < 4; ++cb) {
            const int c = c0 + cb * 16 + ln;
            const float u = bf2f(PR[(row0 + i) * 2048 + c]);
            OC[(row0 + i) * 1024 + c] = f2bf(u * (acc[cb][j] + bsv));
        }
    }
    __syncthreads();
}

__device__ __noinline__ void xattn_sample_item(ArgsP a, LAS unsigned char* lds, int l, int item) {
    const int tid = threadIdx.x, lane = tid & 63, wave = tid >> 6;
    const int b = item >> 2, h = item & 3;
    bf16_t* OC = (bf16_t*)(a->ws + WS_OC);
    const float* Kc = a->in[3] + ((size_t)(l * 128 + b) * 256) * 1024 + h * 256;
    const float* Vc = a->in[4] + ((size_t)(l * 128 + b) * 256) * 1024 + h * 256;
    LAS float* sc = (LAS float*)lds;
    LAS float* red = sc + 256;
    LAS float* op = red + 16;
    f32x4 q = (f32x4){0.f, 0.f, 0.f, 0.f};
#pragma unroll
    for (int ks = 0; ks < 4; ++ks) q += *(const f32x4*)((const float*)(a->ws + WS_PART) + ((size_t)ks * 256 + b) * 1024 + h * 256 + lane * 4);
    float mx = -1e30f;
#pragma unroll 1
    for (int i0 = 0; i0 < 32; i0 += 8) {
        float sv[8];
#pragma unroll
        for (int i = 0; i < 8; ++i) { const f32x4 k = __builtin_nontemporal_load((const f32x4*)(Kc + (size_t)(wave * 32 + i0 + i) * 1024 + lane * 4));
            sv[i] = (q[0] * k[0] + q[1] * k[1]) + (q[2] * k[2] + q[3] * k[3]); }
#pragma unroll
        for (int i = 0; i < 8; ++i) { const float sres = wave_sum(sv[i]) * 0.0625f; mx = fmaxf(mx, sres); if (lane == 0) sc[wave * 32 + i0 + i] = sres; }
    }
    if (lane == 0) red[wave] = mx;
    __syncthreads();
    float gmx = red[0];
#pragma unroll
    for (int k = 1; k < 8; ++k) gmx = fmaxf(gmx, red[k]);
    float psum = 0.f; f32x4 o = (f32x4){0.f, 0.f, 0.f, 0.f};
#pragma unroll 1
    for (int i0 = 0; i0 < 32; i0 += 8) {
        f32x4 vv[8];
#pragma unroll
        for (int i = 0; i < 8; ++i) vv[i] = __builtin_nontemporal_load((const f32x4*)(Vc + (size_t)(wave * 32 + i0 + i) * 1024 + lane * 4));
#pragma unroll
        for (int i = 0; i < 8; ++i) { const float p = __expf(sc[wave * 32 + i0 + i] - gmx); psum += p; o += vv[i] * p; }
    }
    if (lane == 0) red[8 + wave] = psum;
    *(LAS f32x4*)(op + wave * 256 + lane * 4) = o;
    __syncthreads();
    if (tid < 256) {
        float tot = 0.f, ov = 0.f;
#pragma unroll
        for (int k = 0; k < 8; ++k) { tot += red[8 + k]; ov += op[k * 256 + tid]; }
        OC[(size_t)(MP + b) * 1024 + h * 256 + tid] = f2bf(ov / tot);
    }
    __syncthreads();
}


#define XB_TMO      128
#define XB_XCNT(j)  (256  + 64 * (j))
#define XB_XSUB(j)  (1280 + 64 * (j))
#define XB_XGEN(j)  (2304 + 64 * (j))
#define XB_TOP      3328
#define XB_TOPGEN   3392
#define XCD_BAR_WORDS 3456
#define XB_SPIN_CAP (1u << 20)
__device__ __forceinline__ unsigned xb_ld(unsigned* p)              { return __hip_atomic_load(p, __ATOMIC_RELAXED, __HIP_MEMORY_SCOPE_AGENT); }
__device__ __forceinline__ unsigned xb_add(unsigned* p, unsigned v) { return __hip_atomic_fetch_add(p, v, __ATOMIC_RELAXED, __HIP_MEMORY_SCOPE_AGENT); }
__device__ __forceinline__ unsigned xb_xcc_id() { return (unsigned)__builtin_amdgcn_s_getreg((3 << 11) | 20) & 0xFu; }
#define XB_SPIN(cond, bar) do { unsigned _sp = 0; while (cond) { __builtin_amdgcn_s_sleep(1); \
    if ((++_sp & 255u) == 0u) { if (xb_ld(&(bar)[XB_TMO])) break; if (_sp > XB_SPIN_CAP) { atomicAdd(&(bar)[XB_TMO], 1u); break; } } } } while (0)
struct XcdBarrier { unsigned* bar; unsigned x; volatile LAS unsigned* st; };
__device__ __forceinline__ XcdBarrier xcd_barrier_post(unsigned* bar, volatile LAS unsigned* st) {
    XcdBarrier b; b.bar = bar; b.x = xb_xcc_id(); b.st = st;
    if (threadIdx.x == 0) (void)xb_add(&bar[XB_XCNT(b.x)], 1u);
    return b;
}
__device__ __forceinline__ void xcd_barrier_complete(unsigned* bar, unsigned x, unsigned& nloc, unsigned& nx) {
    const unsigned G = gridDim.x * gridDim.y * gridDim.z;
    unsigned sum, cnt, mine, sp = 0u;
    for (;;) {
        sum = 0u; cnt = 0u; mine = 0u;
#pragma unroll
        for (unsigned j = 0; j < 16; ++j) { const unsigned c = xb_ld(&bar[XB_XCNT(j)]); sum += c; cnt += (c > 0u) ? 1u : 0u; mine = (j == x) ? c : mine; }
        if (sum == G) break;
        __builtin_amdgcn_s_sleep(1);
        if ((++sp & 255u) == 0u) { if (xb_ld(&bar[XB_TMO])) break; if (sp > XB_SPIN_CAP) { atomicAdd(&bar[XB_TMO], 1u); break; } }
    }
    nloc = mine > 0u ? mine : 1u; nx = cnt > 0u ? cnt : 1u;
}
__device__ __forceinline__ void xcd_barrier(const XcdBarrier& b) {
    asm volatile("s_waitcnt vmcnt(0)" ::: "memory");
    __syncthreads();
    if (threadIdx.x == 0) {
        unsigned* bar = b.bar;
        __builtin_amdgcn_s_waitcnt(0);
        unsigned nloc = b.st[0], nx = b.st[1];
        if (nloc == 0u) { xcd_barrier_complete(bar, b.x, nloc, nx); b.st[0] = nloc; b.st[1] = nx; }
        const unsigned old = xb_add(&bar[XB_XSUB(b.x)], 1u);
        const unsigned gen = old / nloc;
        if (old + 1u == (gen + 1u) * nloc) {
            __builtin_amdgcn_fence(__ATOMIC_RELEASE, "agent");
            asm volatile("s_waitcnt vmcnt(0)" ::: "memory");
            const unsigned og = xb_add(&bar[XB_TOP], 1u);
            const unsigned tg = og / nx;
            if (og + 1u == (tg + 1u) * nx) xb_add(&bar[XB_TOPGEN], 1u);
            else XB_SPIN(xb_ld(&bar[XB_TOPGEN]) == tg, bar);
            __builtin_amdgcn_fence(__ATOMIC_ACQUIRE, "agent");
            xb_add(&bar[XB_XGEN(b.x)], 1u);
            asm volatile("s_waitcnt vmcnt(0)" ::: "memory");
        } else {
            XB_SPIN(xb_ld(&bar[XB_XGEN(b.x)]) == gen, bar);
            __builtin_amdgcn_fence(__ATOMIC_ACQUIRE, "agent");
            asm volatile("s_waitcnt vmcnt(0)" ::: "memory");
        }
    }
    __syncthreads();
}

__global__ void __launch_bounds__(512, 2) fwd_kernel(Args a_) {
    extern __shared__ __attribute__((aligned(16))) unsigned char lds_raw[];
    LAS unsigned char* lds = (LAS unsigned char*)lds_raw;
    cg::grid_group grid = cg::this_grid();
    const int G = gridDim.x, bx = blockIdx.x;
    const int ph_lo = a_.ph_lo, ph_hi = a_.ph_hi;
    int rep_done = 0; (void)rep_done;
    volatile LAS unsigned* bst = (volatile LAS unsigned*)(lds + LDS_STAGE);
    if (threadIdx.x < 2) bst[threadIdx.x] = 0u;
    __syncthreads();
    const XcdBarrier xb = xcd_barrier_post((unsigned*)(a_.ws + WS_BAR), bst);
    if (ph_lo < 0) grid.sync();
    for (int ph = ph_lo; ph < ph_hi; ++ph) {
        ArgsP a = (ArgsP)__builtin_amdgcn_kernarg_segment_ptr();
        asm volatile("" : "+s"(a));
        unsigned char* ws = a->ws;
        bf16_t* XB = (bf16_t*)(ws + WS_XB); bf16_t* WIDE = (bf16_t*)(ws + WS_WIDE); bf16_t* OC = (bf16_t*)(ws + WS_OC);
        bf16_t* QB = (bf16_t*)(ws + WS_QB); bf16_t* PB = (bf16_t*)(ws + WS_PB);
        float* T = (float*)(ws + WS_T); float* XRES = (float*)(ws + WS_XRES);
        if (ph == 0) { prep_phase(a, lds); }
        else {
            const int l = (ph - 1) / 17 >= 1 ? 1 : 0;
            const int q = ph - 1 - l * 17;
            int code;
            if (l == 0) code = q; else code = q < 3 ? q : (q < 8 ? 100 + (q - 3) : q + 1);
            EpiA e{};
            if (code == 0 || code == 14) {
                const int ls = l * 2 + (code == 14 ? 1 : 0);
                if (ph == 1) {
                    GemmP g = mk_gemm(ws + WS_MEMB, 1024, ws + WS_WKV, 1024, 1024, 8, 16); g.rev = 1;
                    EpiA ek{}; ek.f0 = a->out; ek.b0 = (bf16_t*)(ws + WS_KB); ek.b1 = (bf16_t*)(ws + WS_VT);
                    gemm_phase<EPI_KV>(lds, g, ek);
                }
                GemmP g = mk_gemm(XB, 1024, (bf16_t*)(ws + WS_WGU) + (size_t)ls * 5632 * 1024, 1024, 1024, MT / BM, 22);
                e.b0 = WIDE; e.ldc = FF;
                gemm_phase<EPI_SWIGLU>(lds, g, e);
            } else if (code == 1 || code == 15) {
                const int ls = l * 2 + (code == 15 ? 1 : 0);
                const bf16_t* Wd = (bf16_t*)(ws + WS_WDN) + (size_t)ls * 1024 * 2816;
                GemmP g = mk_gemm(WIDE, FF, Wd, FF, FF, MP / BM, 4);
                e.b0 = (bf16_t*)T; e.b1 = XB; e.s0 = ALPHA; e.s1 = 0.5f; e.f0 = (float*)(ws + WS_PART); g.nsplit = 11;
                gemm_phase<EPI_RES>(lds, g, e);
            } else if (code == 2) { ln_phase(a, l, 0, false, 11, 0.5f); }
            else if (code == 16) { ln_phase(a, l, 3, l == 1, 11, 0.5f); }
            else if (code == 8 || code == 104) { ln_phase(a, l, 1, false, 4, 1.f); }
            else if (code == 13) { ln_phase(a, l, 2, false, 4, 1.f); }
            else if (code == 3) {
                GemmP g = mk_gemm(XB, 1024, ws + WS_WABIN, 1024, 1024, MT / BM, ABN / BM);
                e.b0 = WIDE; e.ldc = ABN; e.flag = 0;
                gemm_phase<EPI_BF16>(lds, g, e);
            } else if (code == 4) {
                for (int it = bx; it < 1024; it += G) gdn_prep_item(a, lds, it);
                for (int it = bx; it < 512; it += G) gdn_sample_item(a, lds, it);
            } else if (code == 5) {
                for (int it = bx; it < 256; it += G) { int item = it; if (G == 256) { const int xcd = it & 7, k = it >> 3; item = (((k >> 3) * 8 + xcd) << 3) | (k & 7); } gdn_scan_item(a, lds, item); }
            } else if (code == 6) {
                for (int it = bx; it < 512; it += G) conf_item(a, lds, it);
                for (int it = bx; it < 128; it += G) conf_sample_item(a, lds, it);
                gdn_finish_phase(a);
            } else if (code == 7) {
                GemmP g = mk_gemm(OC, 1024, ws + WS_WABOUT, 1024, 1024, MP / BM, 4);
                e.b0 = (bf16_t*)T; e.b1 = XB; e.s0 = ALPHA; e.s1 = 1.f; e.f0 = (float*)(ws + WS_PART); g.nsplit = 4;
                gemm_phase<EPI_RES>(lds, g, e);
            } else if (code == 100) {
                GemmP g = mk_gemm(XB, 1024, ws + WS_WGMIN, 1024, 1024, MT / BM, 8);
                e.b0 = WIDE; e.ldc = 2048; e.flag = 1;
                gemm_phase<EPI_BF16>(lds, g, e);
            } else if (code == 101) { gm_ln_phase(a); }
            else if (code == 102) { for (int it = bx; it < 128 * 16; it += G) gm_mix_item(a, lds, it); }
            else if (code == 103) {
                GemmP g = mk_gemm(OC, 1024, ws + WS_WGMOUT, 1024, 1024, MP / BM, 4);
                e.b0 = (bf16_t*)T; e.b1 = XB; e.s0 = ALPHA; e.s1 = 1.f; e.f0 = (float*)(ws + WS_PART); g.nsplit = 4;
                gemm_phase<EPI_RES>(lds, g, e);
            } else if (code == 9) {
                const bf16_t* Wq = (bf16_t*)(ws + WS_WQ) + (size_t)l * 1024 * 1024;
                GemmP g = mk_gemm(XB, 1024, Wq, 1024, 1024, MP / BM, 4);
                e.b0 = QB; e.ldc = 1024; e.flag = 0; e.f0 = (float*)(ws + WS_PART); g.nsplit = 4;
                gemm_phase<EPI_BF16>(lds, g, e);
            } else if (code == 10) {
                GemmP g = mk_gemm(QB, 1024, ws + WS_KB, 1024, 256, 64, 4); g.A = (const char*)QB; g.B = (const char*)((bf16_t*)(ws + WS_KB) + (size_t)l * 8 * 256 * 1024);
                g.a_pm = (long)256 * 1024 * 2; g.a_pn = 256 * 2; g.b_pb = (long)256 * 1024 * 2; g.b_pn = 256 * 2; g.lda = 1024; g.ldb = 1024; g.nt = 4; g.nM = 64; g.nN = 4;
                e.b0 = PB; e.f0 = (float*)(ws + WS_ROWSUM) + (size_t)l * MP * 4;
                gemm_phase<EPI_SCORES>(lds, g, e);
                for (int it = bx; it < 512; it += G) xattn_sample_item(a, lds, l, it);
#if defined(DUP_CLASS) && DUP_CLASS == 8
                for (int it = bx; it < 512; it += G) xattn_sample_item(a, lds, l, it);
#endif
            } else if (code == 11) {
                GemmP g = mk_gemm(PB, 1024, ws + WS_VT, 256, 256, 64, 4); g.A = (const char*)PB; g.B = (const char*)((bf16_t*)(ws + WS_VT) + (size_t)l * 8 * 1024 * 256);
                g.a_pm = (long)256 * 1024 * 2; g.a_pn = 256 * 2; g.b_pb = (long)1024 * 256 * 2; g.b_pn = (long)256 * 256 * 2; g.lda = 1024; g.ldb = 256; g.nt = 4; g.nM = 64; g.nN = 4;
                e.b0 = OC; e.f1 = (const float*)(ws + WS_ROWSUM) + (size_t)l * MP * 4;
                gemm_phase<EPI_PV>(lds, g, e);
            } else if (code == 12) {
                const bf16_t* Wo = (bf16_t*)(ws + WS_WO) + (size_t)l * 1024 * 1024;
                GemmP g = mk_gemm(OC, 1024, Wo, 1024, 1024, MP / BM, 4);
                e.b0 = (bf16_t*)T; e.b1 = XB; e.s0 = ALPHA; e.s1 = 1.f; e.f0 = (float*)(ws + WS_PART); g.nsplit = 4;
                gemm_phase<EPI_RES>(lds, g, e);
            }
        }
#ifdef DUP_CLASS
        {
            int code_ = -1;
            if (ph > 0) { const int l_ = (ph - 1) / 17 >= 1 ? 1 : 0, q_ = ph - 1 - l_ * 17; code_ = l_ == 0 ? q_ : (q_ < 3 ? q_ : (q_ < 8 ? 100 + (q_ - 3) : q_ + 1)); }
            bool dup = false;
            if (DUP_CLASS == 1) dup = (code_ == 0 || code_ == 1 || code_ == 3 || code_ == 7 || code_ == 9 || code_ == 11 || code_ == 12 || code_ == 14 || code_ == 15 || code_ == 100 || code_ == 103);
            if (DUP_CLASS == 2) dup = (ph == 0 || code_ == 2 || code_ == 8 || code_ == 13 || code_ == 16 || code_ == 104 || code_ == 101);
            if (DUP_CLASS == 3) dup = (code_ == 4 || code_ == 5 || code_ == 6 || code_ == 102);
            if (DUP_CLASS == 4) dup = (code_ == 5);
            if (DUP_CLASS == 5) dup = (ph == 0);
            if (DUP_CLASS == 6) dup = (code_ == 4);
            if (DUP_CLASS == 9) dup = (code_ == 6);
            if (DUP_CLASS == 11) dup = (code_ == 0 || code_ == 14);
            if (DUP_CLASS == 12) dup = (code_ == 1 || code_ == 15);
            if (DUP_CLASS == 13) dup = (code_ == 7 || code_ == 103 || code_ == 12 || code_ == 9);
            if (DUP_CLASS == 10) dup = (code_ == 102 || code_ == 101);
            if (dup && !rep_done) { rep_done = 1; --ph; continue; }
            rep_done = 0;
        }
#endif
        if (ph + 1 < ph_hi) xcd_barrier(xb);
#if defined(DUP_CLASS) && DUP_CLASS == 7
        if (ph + 1 < ph_hi) xcd_barrier(xb);
#endif
    }
#ifdef DIAG_HI
    {
        grid.sync();
        ArgsP a = (ArgsP)__builtin_amdgcn_kernarg_segment_ptr();
        const float* XR = (const float*)(a->ws + WS_XRES); float* o = a->out;
        for (size_t i = (size_t)blockIdx.x * 512 + threadIdx.x; i < (size_t)MV * 1024; i += (size_t)gridDim.x * 512) { float vv = (i < (size_t)8 * 4 * 128 * 128) ? a->out[O_DNS_P + i] * 1000.37f : 0.f; o[i] = vv - floorf(vv); }
    }
#endif
}

extern "C" void kernel_launch(void* const* d_in, const int* in_sizes, int n_in, void* d_out, int out_size, void* d_ws, size_t ws_size, hipStream_t stream) {
    static int grid = 0;
    if (grid == 0) {
        if (n_in != 33 || (size_t)out_size != O_END || ws_size < WS_END) { fprintf(stderr, "kernel_launch: unexpected shapes n_in %d out %d (want %zu) ws %zu (want %zu)\n", n_in, out_size, (size_t)O_END, ws_size, (size_t)WS_END); grid = -1; return; }
        int dev = 0, cus = 0, per_cu = 0;
        hipGetDevice(&dev);
        hipDeviceGetAttribute(&cus, hipDeviceAttributeMultiprocessorCount, dev);
        if (hipFuncSetAttribute((const void*)fwd_kernel, hipFuncAttributeMaxDynamicSharedMemorySize, LDS_BYTES) != hipSuccess) { fprintf(stderr, "kernel_launch: hipFuncSetAttribute failed\n"); grid = -1; return; }
        if (hipOccupancyMaxActiveBlocksPerMultiprocessor(&per_cu, (const void*)fwd_kernel, 512, LDS_BYTES) != hipSuccess || per_cu < 1) { fprintf(stderr, "kernel_launch: occupancy query says %d\n", per_cu); per_cu = 1; }
        (void)hipGetLastError();
        grid = cus;
    }
    if (grid < 0) return;
    if (hipMemsetAsync((char*)d_ws + WS_BAR, 0, (size_t)3456 * 4, stream) != hipSuccess) { fprintf(stderr, "kernel_launch: memset of barrier words failed\n"); return; }
    Args a{};
    for (int i = 0; i < 33; ++i) a.in[i] = (const float*)d_in[i];
    a.out = (float*)d_out; a.ws = (unsigned char*)d_ws;
#if N_PER_PHASE_LAUNCH
    for (int ph = 0; ph < NPHASES; ++ph) {
        a.ph_lo = ph; a.ph_hi = ph + 1;
        void* args[] = {&a};
        hipError_t e = hipLaunchCooperativeKernel((const void*)fwd_kernel, dim3(grid), dim3(512), args, LDS_BYTES, stream);
        if (e != hipSuccess) { fprintf(stderr, "launch failed: %s\n", hipGetErrorString(e)); return; }
    }
#else
#ifdef DIAG_HI
    a.ph_lo = 0; a.ph_hi = DIAG_HI;
#else
    a.ph_lo = 0; a.ph_hi = NPHASES;
#endif
    void* args[] = {&a};
    hipError_t e = hipLaunchCooperativeKernel((const void*)fwd_kernel, dim3(grid), dim3(512), args, LDS_BYTES, stream);
    if (e != hipSuccess) fprintf(stderr, "cooperative launch failed: %s (grid %d)\n", hipGetErrorString(e), grid);
#endif
}
```

```cpp
#include <hip/hip_runtime.h>
#include <hip/hip_cooperative_groups.h>
#include <cstdio>
#include <cstdint>
namespace cg = cooperative_groups;

#ifndef N_PER_PHASE_LAUNCH
#define N_PER_PHASE_LAUNCH 0
#endif

#define LAS __attribute__((address_space(3)))
typedef unsigned short bf16_t;
typedef short bf16x8 __attribute__((ext_vector_type(8)));
typedef float f32x4 __attribute__((ext_vector_type(4)));
typedef float f32x2 __attribute__((ext_vector_type(2)));
typedef unsigned u32x4 __attribute__((ext_vector_type(4)));
typedef unsigned u32x2 __attribute__((ext_vector_type(2)));

constexpr int D = 1024, FF = 2816, MP = 16384, MS = 128, MV = 16512, MT = 16640, SEQ = 2048, NB = 8;
constexpr int ABN = 3328;
constexpr float ALPHA = 1.4142135623730951f;
constexpr float LN_EPS = 1e-5f;
constexpr int LDS_STAGE = 131072;
constexpr int LDS_BYTES = LDS_STAGE + 64;
constexpr int NPHASES = 34;

constexpr size_t al256(size_t x) { return (x + 255) & ~(size_t)255; }
constexpr size_t WS_WGU = 0;
constexpr size_t WS_WDN = al256(WS_WGU + (size_t)4 * 5632 * 1024 * 2);
constexpr size_t WS_WQ = al256(WS_WDN + (size_t)4 * 1024 * 2816 * 2);
constexpr size_t WS_WO = al256(WS_WQ + (size_t)2 * 1024 * 1024 * 2);
constexpr size_t WS_WKV = al256(WS_WO + (size_t)2 * 1024 * 1024 * 2);
constexpr size_t WS_WABIN = al256(WS_WKV + (size_t)4096 * 1024 * 2);
constexpr size_t WS_WABOUT = al256(WS_WABIN + (size_t)ABN * 1024 * 2);
constexpr size_t WS_WGMIN = al256(WS_WABOUT + (size_t)1024 * 1024 * 2);
constexpr size_t WS_WGMOUT = al256(WS_WGMIN + (size_t)2048 * 1024 * 2);
constexpr size_t WS_WGMS = al256(WS_WGMOUT + (size_t)1024 * 1024 * 2);
constexpr size_t WS_MEMB = al256(WS_WGMS + (size_t)4 * 128 * 128 * 2);
constexpr size_t WS_KB = al256(WS_MEMB + (size_t)2048 * 1024 * 2);
constexpr size_t WS_VT = al256(WS_KB + (size_t)2 * 8 * 256 * 1024 * 2);
constexpr size_t WS_XRES = al256(WS_VT + (size_t)2 * 8 * 1024 * 256 * 2);
constexpr size_t WS_XB = al256(WS_XRES + (size_t)MT * 1024 * 4);
constexpr size_t WS_T = al256(WS_XB + (size_t)MT * 1024 * 2);
constexpr size_t WS_WIDE = al256(WS_T + (size_t)MT * 1024 * 4);
constexpr size_t WS_OC = al256(WS_WIDE + (size_t)MT * ABN * 2);
constexpr size_t WS_QB0 = al256(WS_OC + (size_t)MT * 1024 * 2);
constexpr size_t WS_PB0 = al256(WS_QB0 + (size_t)MT * 1024 * 2);
constexpr size_t WS_ROWSUM = al256(WS_PB0 + (size_t)MT * 1024 * 2);
constexpr size_t WS_GU = al256(WS_ROWSUM + (size_t)2 * MP * 4 * 4);
constexpr size_t WS_GW = al256(WS_GU + (size_t)1024 * 64 * 128 * 4);
constexpr size_t WS_GQG = al256(WS_GW + (size_t)1024 * 64 * 128 * 2);
constexpr size_t WS_GKTT = al256(WS_GQG + (size_t)1024 * 64 * 128 * 2);
constexpr size_t WS_GQK = al256(WS_GKTT + (size_t)1024 * 128 * 64 * 2);
constexpr size_t WS_GGL = al256(WS_GQK + (size_t)1024 * 64 * 64 * 2);
constexpr size_t WS_ORAW0 = al256(WS_GGL + (size_t)1024 * 32 * 4);
constexpr size_t WS_BAR = al256(WS_ORAW0 + (size_t)MV * 512 * 4);
constexpr size_t WS_PART = al256(WS_BAR + (size_t)3456 * 4);
constexpr size_t WS_END = al256(WS_PART + (size_t)11 * 256 * 1024 * 4);

constexpr size_t WS_PB = WS_T;
constexpr size_t WS_ORAW = WS_T;
constexpr size_t WS_QB = WS_GU;
static_assert((size_t)MV * 512 * 4 <= (size_t)MT * 1024 * 4 && (size_t)MT * 1024 * 2 <= (size_t)1024 * 64 * 128 * 4 + (size_t)1024 * 64 * 128 * 2, "alias slots too small");
constexpr size_t O_Y = 0;
constexpr size_t O_MK = O_Y + (size_t)MV * 1024;
constexpr size_t O_MV = O_MK + (size_t)2 * 8 * 256 * 1024;
constexpr size_t O_DNS_P = O_MV + (size_t)2 * 8 * 256 * 1024;
constexpr size_t O_DNC_P = O_DNS_P + (size_t)8 * 4 * 128 * 128;
constexpr size_t O_CCC_P = O_DNC_P + (size_t)8 * 3 * 1536;
constexpr size_t O_DNS_S = O_CCC_P + (size_t)8 * 30 * 512;
constexpr size_t O_DNC_S = O_DNS_S + (size_t)128 * 4 * 128 * 128;
constexpr size_t O_CCC_S = O_DNC_S + (size_t)128 * 3 * 1536;
constexpr size_t O_GMV_S = O_CCC_S + (size_t)128 * 30 * 512;
constexpr size_t O_END = O_GMV_S + (size_t)128 * 1024;

struct Args {
    const float* in[33];
    float* out;
    unsigned char* ws;
    int ph_lo, ph_hi;
};

typedef const __attribute__((address_space(4))) Args* ArgsP;

typedef __bf16 bf16x2_t __attribute__((ext_vector_type(2)));
__device__ __forceinline__ unsigned cvt_pk_bf16(float lo, float hi) { const f32x2 v = (f32x2){lo, hi}; const bf16x2_t r = __builtin_convertvector(v, bf16x2_t); return __builtin_bit_cast(unsigned, r); }
__device__ __forceinline__ bf16_t f2bf(float f) { return (bf16_t)(cvt_pk_bf16(f, 0.f) & 0xffffu); }
__device__ __forceinline__ float bf2f(bf16_t b) { return __uint_as_float(((unsigned)b) << 16); }
__device__ __forceinline__ float bflo(unsigned w) { return __uint_as_float(w << 16); }
__device__ __forceinline__ float bfhi(unsigned w) { return __uint_as_float(w & 0xffff0000u); }
__device__ __forceinline__ float fexp(float x) { return __builtin_amdgcn_exp2f(x * 1.4426950408889634f); }
__device__ __forceinline__ float siluf(float x) { return x * __builtin_amdgcn_rcpf(1.f + fexp(-x)); }
__device__ __forceinline__ float sigmf(float x) { return __builtin_amdgcn_rcpf(1.f + fexp(-x)); }
__device__ __forceinline__ float geluf(float x) { const float t = 1.5957691216057308f * (x + 0.044715f * x * x * x); return x * __builtin_amdgcn_rcpf(1.f + fexp(-t)); }
__device__ __forceinline__ float wave_sum(float v) {
#pragma unroll
    for (int o = 1; o < 64; o <<= 1) v += __shfl_xor(v, o);
    return v;
}
__device__ __forceinline__ float wave_max(float v) {
#pragma unroll
    for (int o = 1; o < 64; o <<= 1) v = fmaxf(v, __shfl_xor(v, o));
    return v;
}
#define LDS_WAIT() asm volatile("s_waitcnt lgkmcnt(0)" ::: "memory")

constexpr int BM = 256, BK = 64, HALF = 128, HTB = HALF * BK * 2, NXCD = 8, WGM = 8;
__device__ __forceinline__ int lds_byte(int r, int c) { const int st = (r >> 4) * 2 + (c >> 5), rr = r & 15, cc = c & 31, ob = rr * 64 + cc * 2; return st * 1024 + (ob ^ (((ob >> 9) & 1) << 5)); }
__device__ __forceinline__ void stage_rc(int b, int& R, int& C) { const int st = b / 1024, sb = b % 1024, swz = sb ^ (((sb >> 9) & 1) << 5); R = (st >> 1) * 16 + swz / 64; C = (st & 1) * 32 + (swz % 64) / 2; }
__device__ __forceinline__ int perm32(int rho) { const int n = rho >> 4, i = rho & 15; return 8 * (i >> 2) + 4 * n + (i & 3); }

struct GemmP {
    const char* A; const char* B;
    long a_pm, a_pn, b_pb, b_pn, a_ks, b_ks;
    int lda, ldb, nt, nM, nN, pn_mask, pn_shift, nsplit, rev;
};
struct EpiA { float* f0; const float* f1; bf16_t* b0; bf16_t* b1; int ldc; float s0, s1; int flag; };

__device__ __forceinline__ bool unit_next(int i, int nM, int nN, int& pm, int& pn, int rev = 0) {
    const int nwg = nM * nN, G = gridDim.x;
    const long L = (long)i * G + (rev ? G - 1 - (int)blockIdx.x : (int)blockIdx.x); if (L >= nwg) return false;
    int wgid = (int)L; { const int q = nwg / NXCD, r = nwg % NXCD, xcd = wgid % NXCD, off = wgid / NXCD; wgid = (xcd < r ? xcd * (q + 1) : r * (q + 1) + (xcd - r) * q) + off; }
    const int nig = WGM * nN, gid = wgid / nig, fm = gid * WGM, gsz = (nM - fm) < WGM ? (nM - fm) : WGM;
    pm = fm + ((wgid % nig) % gsz); pn = (wgid % nig) / gsz; return true;
}

enum { EPI_SWIGLU = 0, EPI_RES = 1, EPI_BF16 = 2, EPI_KV = 3, EPI_SCORES = 4, EPI_PV = 5, EPI_PART = 6 };

template <int MODE>
__device__ __forceinline__ void epilogue(const f32x4 (&acc)[2][2][4][2], int pm, int pn, int wr, int wc, int fr, int fq, const EpiA& e) {
    const int row0 = pm * BM + wr * 64 + fr;
    if constexpr (MODE == EPI_SWIGLU) {
        const int col0 = pn * 128 + wc * 32 + 8 * fq;
#pragma unroll
        for (int ai = 0; ai < 2; ++ai)
#pragma unroll
            for (int m = 0; m < 4; ++m) {
                const size_t row = (size_t)(row0 + ai * HALF + m * 16);
                float h[8];
#pragma unroll
                for (int n = 0; n < 2; ++n)
#pragma unroll
                    for (int j = 0; j < 4; ++j) h[n * 4 + j] = siluf(acc[ai][0][m][n][j]) * acc[ai][1][m][n][j];
                u32x4 w; w.x = cvt_pk_bf16(h[0], h[1]); w.y = cvt_pk_bf16(h[2], h[3]); w.z = cvt_pk_bf16(h[4], h[5]); w.w = cvt_pk_bf16(h[6], h[7]);
                *(u32x4*)(e.b0 + row * e.ldc + col0) = w;
            }
    } else if constexpr (MODE == EPI_RES) {
        const int col0 = pn * BM + wc * 32 + 4 * fq;
#pragma unroll
        for (int ai = 0; ai < 2; ++ai) {
            u32x2 xr[4][2][2];
#pragma unroll
            for (int m = 0; m < 4; ++m)
#pragma unroll
                for (int bj = 0; bj < 2; ++bj)
#pragma unroll
                    for (int n = 0; n < 2; ++n) xr[m][bj][n] = *(const u32x2*)(e.b1 + (size_t)(row0 + ai * HALF + m * 16) * 1024 + col0 + bj * HALF + n * 16);
#pragma unroll
            for (int m = 0; m < 4; ++m)
#pragma unroll
                for (int bj = 0; bj < 2; ++bj)
#pragma unroll
                    for (int n = 0; n < 2; ++n) {
                        const u32x2 xw = xr[m][bj][n]; const f32x4 x = (f32x4){bflo(xw.x), bfhi(xw.x), bflo(xw.y), bfhi(xw.y)};
                        const f32x4 t = x * e.s0 + acc[ai][bj][m][n] * e.s1;
                        u32x2 w; w.x = cvt_pk_bf16(t[0], t[1]); w.y = cvt_pk_bf16(t[2], t[3]);
                        *(u32x2*)(e.b0 + (size_t)(row0 + ai * HALF + m * 16) * 1024 + col0 + bj * HALF + n * 16) = w;
                    }
            asm volatile("" ::: "memory");
        }
    } else if constexpr (MODE == EPI_BF16) {
        const int col0 = pn * BM + wc * 32 + 8 * fq;
#pragma unroll
        for (int ai = 0; ai < 2; ++ai)
#pragma unroll
            for (int m = 0; m < 4; ++m) {
                bf16_t* rowp = e.b0 + (size_t)(row0 + ai * HALF + m * 16) * e.ldc + col0;
#pragma unroll
                for (int bj = 0; bj < 2; ++bj) {
                    f32x4 v0 = acc[ai][bj][m][0], v1 = acc[ai][bj][m][1];
                    if (e.flag) {
#pragma unroll
                        for (int j = 0; j < 4; ++j) { v0[j] = geluf(v0[j]); v1[j] = geluf(v1[j]); }
                    }
                    u32x4 w; w.x = cvt_pk_bf16(v0[0], v0[1]); w.y = cvt_pk_bf16(v0[2], v0[3]); w.z = cvt_pk_bf16(v1[0], v1[1]); w.w = cvt_pk_bf16(v1[2], v1[3]);
                    *(u32x4*)(rowp + bj * HALF) = w;
                }
            }
    } else if constexpr (MODE == EPI_KV) {
        const int sel = pn >> 2, l = sel >> 1, kv = sel & 1;
        const int e0 = (pn & 3) * BM + wc * 32 + 4 * fq;
        float* ob = e.f0 + (kv ? O_MV : O_MK) + (size_t)(l * 8 + pm) * 256 * 1024;
        bf16_t* kb = e.b0 + (size_t)(l * 8 + pm) * 256 * 1024;
        bf16_t* vt = e.b1 + (size_t)(l * 8 + pm) * 1024 * 256;
#pragma unroll
        for (int ai = 0; ai < 2; ++ai)
#pragma unroll
            for (int m = 0; m < 4; ++m) {
                const int mm = wr * 64 + fr + ai * HALF + m * 16;
#pragma unroll
                for (int bj = 0; bj < 2; ++bj)
#pragma unroll
                    for (int n = 0; n < 2; ++n) {
                        const int ee = e0 + bj * HALF + n * 16;
                        const f32x4 v = acc[ai][bj][m][n];
                        __builtin_nontemporal_store(v, (f32x4*)(ob + (size_t)mm * 1024 + ee));
                        if (kv == 0) { u32x2 w; w.x = cvt_pk_bf16(v[0], v[1]); w.y = cvt_pk_bf16(v[2], v[3]); *(u32x2*)(kb + (size_t)mm * 1024 + ee) = w; }
                        else {
#pragma unroll
                            for (int j = 0; j < 4; ++j) vt[(size_t)(ee + j) * 256 + mm] = f2bf(v[j]);
                        }
                    }
            }
    } else if constexpr (MODE == EPI_SCORES) {
        const int col0 = pn * BM + wc * 32 + 8 * fq;
#pragma unroll
        for (int ai = 0; ai < 2; ++ai)
#pragma unroll
            for (int m = 0; m < 4; ++m) {
                const size_t row = (size_t)(row0 + ai * HALF + m * 16);
                float s = 0.f;
#pragma unroll
                for (int bj = 0; bj < 2; ++bj) {
                    float p[8];
#pragma unroll
                    for (int n = 0; n < 2; ++n)
#pragma unroll
                        for (int j = 0; j < 4; ++j) { p[n * 4 + j] = __builtin_amdgcn_exp2f(acc[ai][bj][m][n][j] * (0.0625f * 1.4426950408889634f)); s += p[n * 4 + j]; }
                    u32x4 w; w.x = cvt_pk_bf16(p[0], p[1]); w.y = cvt_pk_bf16(p[2], p[3]); w.z = cvt_pk_bf16(p[4], p[5]); w.w = cvt_pk_bf16(p[6], p[7]);
                    *(u32x4*)(e.b0 + row * 1024 + col0 + bj * HALF) = w;
                }
                s += __shfl_xor(s, 16); s += __shfl_xor(s, 32);
                if (fq == 0) atomicAdd(e.f0 + row * 4 + pn, s);
            }
    } else if constexpr (MODE == EPI_PART) {
        float* base = e.f0 + (size_t)(pn >> 2) * 256 * 1024 + (size_t)(wr * 64 + fr) * 1024 + (pn & 3) * BM + wc * 32 + 4 * fq;
#pragma unroll
        for (int ai = 0; ai < 2; ++ai)
#pragma unroll
            for (int m = 0; m < 4; ++m)
#pragma unroll
                for (int bj = 0; bj < 2; ++bj)
#pragma unroll
                    for (int n = 0; n < 2; ++n) *(f32x4*)(base + (size_t)(ai * HALF + m * 16) * 1024 + bj * HALF + n * 16) = acc[ai][bj][m][n];
    } else if constexpr (MODE == EPI_PV) {
        const int col0 = pn * BM + wc * 32 + 8 * fq;
        float rs[2][4];
#pragma unroll
        for (int ai = 0; ai < 2; ++ai)
#pragma unroll
            for (int m = 0; m < 4; ++m) rs[ai][m] = e.f1[(size_t)(row0 + ai * HALF + m * 16) * 4 + pn];
#pragma unroll
        for (int ai = 0; ai < 2; ++ai)
#pragma unroll
            for (int m = 0; m < 4; ++m) {
                const size_t row = (size_t)(row0 + ai * HALF + m * 16);
                const float inv = 1.f / rs[ai][m];
#pragma unroll
                for (int bj = 0; bj < 2; ++bj) {
                    const f32x4 v0 = acc[ai][bj][m][0] * inv, v1 = acc[ai][bj][m][1] * inv;
                    u32x4 w; w.x = cvt_pk_bf16(v0[0], v0[1]); w.y = cvt_pk_bf16(v0[2], v0[3]); w.z = cvt_pk_bf16(v1[0], v1[1]); w.w = cvt_pk_bf16(v1[2], v1[3]);
                    *(u32x4*)(e.b0 + row * 1024 + col0 + bj * HALF) = w;
                }
            }
    }
}

template <bool PERMUTED>
__device__ __forceinline__ void epilogue_part(const f32x4 (&acc)[2][2][4][2], int pn, int wr, int wc, int fr, int fq, float* part) {
    float* base = part + (size_t)(pn >> 2) * 256 * 1024 + (size_t)(wr * 64 + fr) * 1024 + (pn & 3) * BM + wc * 32 + (PERMUTED ? 8 * fq : 4 * fq);
#pragma unroll
    for (int ai = 0; ai < 2; ++ai)
#pragma unroll
        for (int m = 0; m < 4; ++m)
#pragma unroll
            for (int bj = 0; bj < 2; ++bj)
#pragma unroll
                for (int n = 0; n < 2; ++n) *(f32x4*)(base + (size_t)(ai * HALF + m * 16) * 1024 + bj * HALF + (PERMUTED ? 4 * n : 16 * n)) = acc[ai][bj][m][n];
}

template <int MODE>
__device__ __forceinline__ void gemm_phase(LAS unsigned char* lds, const GemmP g, const EpiA e) {
    constexpr bool PERM = (MODE == EPI_SWIGLU || MODE == EPI_BF16 || MODE == EPI_SCORES || MODE == EPI_PV);
    int tid_ = threadIdx.x; asm volatile("" : "+v"(tid_));
    const int tid = tid_, wid = __builtin_amdgcn_readfirstlane(tid >> 6), lane = tid & 63, wr = wid >> 2, wc = wid & 3, fr = lane & 15, fq = lane >> 4;
    const int nt = g.nt;
    unsigned voffA[2], voffB[2];
#pragma unroll
    for (int i = 0; i < 2; ++i) { int R, C; stage_rc(tid * 16 + i * 8192, R, C); const int Rb = PERM ? ((R & ~31) + perm32(R & 31)) : R;
        voffA[i] = (unsigned)(R * g.lda + C) * 2u; voffB[i] = (unsigned)(Rb * g.ldb + C) * 2u; }
    const size_t kstep = (size_t)(BK * 2);
    const size_t hstepA = (size_t)HALF * g.lda * 2, hstepB = (size_t)HALF * g.ldb * 2;
    const unsigned ldsw = (unsigned)wid * 1024u;
    const int aoff = lds_byte(wr * 64 + fr, fq * 8), boff = lds_byte(wc * 32 + fr, fq * 8);
#define PG8_SA(b, h) (((b) * 2 + (h)) * HTB)
#define PG8_SB(b, h) ((4 + (b) * 2 + (h)) * HTB)
#define PG8_STAGE(bufoff, gbase, voff) do { _Pragma("unroll") for (int _i = 0; _i < 2; ++_i) \
        __builtin_amdgcn_global_load_lds((const unsigned*)((const char*)(gbase) + (voff)[_i]), (LAS unsigned*)(lds + (bufoff) + ldsw + _i * 8192), 16, 0, 0); } while (0)
#define PG8_LDA(dst, b, h) do { _Pragma("unroll") for (int m = 0; m < 4; ++m) _Pragma("unroll") for (int k = 0; k < 2; ++k) dst[m][k] = *(const LAS bf16x8*)(lds + PG8_SA(b, h) + aoff + m * 2048 + k * 1024); } while (0)
#define PG8_LDB(dst, b, h) do { _Pragma("unroll") for (int n = 0; n < 2; ++n) _Pragma("unroll") for (int k = 0; k < 2; ++k) dst[n][k] = *(const LAS bf16x8*)(lds + PG8_SB(b, h) + boff + n * 2048 + k * 1024); } while (0)
#define PG8_MMA(ai, bj, At, Bt) do { __builtin_amdgcn_s_setprio(1); _Pragma("unroll") for (int m = 0; m < 4; ++m) _Pragma("unroll") for (int n = 0; n < 2; ++n) _Pragma("unroll") for (int k = 0; k < 2; ++k) \
        acc[ai][bj][m][n] = __builtin_amdgcn_mfma_f32_16x16x32_bf16(Bt[n][k], At[m][k], acc[ai][bj][m][n], 0, 0, 0); __builtin_amdgcn_s_setprio(0); } while (0)
#define PG8_WAIT_V(n) asm volatile("s_waitcnt vmcnt(" #n ")" ::: "memory")
#define PG8_WAIT_L(n) asm volatile("s_waitcnt lgkmcnt(" #n ")" ::: "memory")
#define PG8_BAR __builtin_amdgcn_s_barrier()
#define PG8_SCHED __builtin_amdgcn_sched_barrier(0)
    int cpm, cpn, npm = 0, npn = 0, ui = 0; bool csp = false, nsp = false;
    auto get_unit = [&](int i, int& pm, int& pn, bool& sp) -> bool {
        if (unit_next(i, g.nM, g.nN, pm, pn, g.rev)) { sp = false; return true; }
        if (g.nsplit > 0) {
            const int G_ = gridDim.x, bx_ = blockIdx.x, nwg_ = g.nM * g.nN;
            const int nmain = bx_ < nwg_ ? (nwg_ - bx_ + G_ - 1) / G_ : 0;
            const int L = (i - nmain) * G_ + (G_ - 1 - bx_);
            if (i >= nmain && L < 4 * g.nsplit) { pm = 64; pn = L; sp = true; return true; }
        }
        return false;
    };
    auto base_a = [&](int pm, int pn, bool sp) -> const char* {
        return sp ? g.A + (size_t)64 * g.a_pm + (size_t)(pn >> 2) * 512 : g.A + (size_t)pm * g.a_pm + (size_t)(pn & g.pn_mask) * g.a_pn + (size_t)(pn >> g.pn_shift) * g.a_ks; };
    auto base_b = [&](int pm, int pn, bool sp) -> const char* {
        return sp ? g.B + (size_t)(pn & 3) * g.b_pn + (size_t)(pn >> 2) * 512 : g.B + (size_t)(pm >> 3) * g.b_pb + (size_t)(pn & g.pn_mask) * g.b_pn + (size_t)(pn >> g.pn_shift) * g.b_ks; };
    if (!get_unit(0, cpm, cpn, csp)) return;
    f32x4 acc[2][2][4][2];
#pragma unroll
    for (int a = 0; a < 2; ++a)
#pragma unroll
        for (int b = 0; b < 2; ++b)
#pragma unroll
            for (int m = 0; m < 4; ++m)
#pragma unroll
                for (int n = 0; n < 2; ++n) acc[a][b][m][n] = (f32x4){0.f, 0.f, 0.f, 0.f};
    bf16x8 At[4][2], B0[2][2], B1[2][2];
    const char* cA = base_a(cpm, cpn, csp);
    const char* cB = base_b(cpm, cpn, csp);
    PG8_STAGE(PG8_SB(0, 0), cB, voffB); PG8_STAGE(PG8_SA(0, 0), cA, voffA); PG8_STAGE(PG8_SB(0, 1), cB + hstepB, voffB); PG8_STAGE(PG8_SA(0, 1), cA + hstepA, voffA);
    if (wr == 1) PG8_BAR;
    PG8_WAIT_V(4); PG8_BAR;
    PG8_STAGE(PG8_SB(1, 0), cB + kstep, voffB); PG8_STAGE(PG8_SA(1, 0), cA + kstep, voffA); PG8_STAGE(PG8_SB(1, 1), cB + hstepB + kstep, voffB);
    PG8_WAIT_V(6); PG8_BAR;
    for (;;) {
        const bool has_next = get_unit(ui + 1, npm, npn, nsp);
        const char* nA = has_next ? base_a(npm, npn, nsp) : cA;
        const char* nB = has_next ? base_b(npm, npn, nsp) : cB;
        const int cnt = csp ? 4 : nt;
        for (int t = 0; t < cnt; t += 2) {
            const bool last = (t == cnt - 2);
            const char* a1 = cA + (size_t)(t + 1) * kstep;
            const char* a2 = last ? nA : cA + (size_t)(t + 2) * kstep; const char* b2 = last ? nB : cB + (size_t)(t + 2) * kstep;
            const char* a3 = a2 + kstep; const char* b3 = b2 + kstep;
            PG8_LDB(B0, 0, 0); PG8_SCHED; PG8_LDA(At, 0, 0); PG8_STAGE(PG8_SA(1, 1), a1 + hstepA, voffA);
            PG8_WAIT_L(8); PG8_BAR; PG8_WAIT_L(0); PG8_MMA(0, 0, At, B0); PG8_BAR; PG8_SCHED;
            PG8_LDB(B1, 0, 1); PG8_STAGE(PG8_SB(0, 0), b2, voffB);
            PG8_BAR; PG8_WAIT_L(0); PG8_MMA(0, 1, At, B1); PG8_BAR;
            PG8_LDA(At, 0, 1); PG8_STAGE(PG8_SA(0, 0), a2, voffA);
            PG8_BAR; PG8_WAIT_L(0); PG8_MMA(1, 0, At, B0); PG8_BAR; PG8_SCHED;
            PG8_STAGE(PG8_SB(0, 1), b2 + hstepB, voffB);
            PG8_WAIT_V(6); PG8_BAR; PG8_MMA(1, 1, At, B1); PG8_BAR;
            PG8_LDB(B0, 1, 0); PG8_SCHED; PG8_LDA(At, 1, 0); PG8_STAGE(PG8_SA(0, 1), a2 + hstepA, voffA);
            PG8_WAIT_L(8); PG8_BAR; PG8_WAIT_L(0); PG8_MMA(0, 0, At, B0); PG8_BAR; PG8_SCHED;
            PG8_LDB(B1, 1, 1); PG8_STAGE(PG8_SB(1, 0), b3, voffB);
            PG8_BAR; PG8_WAIT_L(0); PG8_MMA(0, 1, At, B1); PG8_BAR;
            PG8_LDA(At, 1, 1); PG8_STAGE(PG8_SA(1, 0), a3, voffA);
            PG8_BAR; PG8_WAIT_L(0); PG8_MMA(1, 0, At, B0); PG8_BAR; PG8_SCHED;
            PG8_STAGE(PG8_SB(1, 1), b3 + hstepB, voffB);
            PG8_WAIT_V(6); PG8_BAR; PG8_MMA(1, 1, At, B1); PG8_BAR;
        }
        if (csp) epilogue_part<PERM>(acc, cpn, wr, wc, fr, fq, e.f0); else epilogue<MODE>(acc, cpm, cpn, wr, wc, fr, fq, e);
        if (!has_next) break;
#pragma unroll
        for (int a = 0; a < 2; ++a)
#pragma unroll
            for (int b = 0; b < 2; ++b)
#pragma unroll
                for (int m = 0; m < 4; ++m)
#pragma unroll
                    for (int n = 0; n < 2; ++n) acc[a][b][m][n] = (f32x4){0.f, 0.f, 0.f, 0.f};
        cpm = npm; cpn = npn; csp = nsp; cA = nA; cB = nB; ++ui;
    }
    PG8_WAIT_V(0);
    if (wr == 0) PG8_BAR;
    PG8_BAR;
#undef PG8_SA
#undef PG8_SB
#undef PG8_STAGE
#undef PG8_LDA
#undef PG8_LDB
#undef PG8_MMA
#undef PG8_WAIT_V
#undef PG8_WAIT_L
#undef PG8_BAR
#undef PG8_SCHED
}

__device__ __forceinline__ GemmP mk_gemm(const void* A, int lda, const void* B, int ldb, int K, int nM, int nN) {
    GemmP g; g.A = (const char*)A; g.B = (const char*)B; g.a_pm = (long)BM * lda * 2; g.a_pn = 0; g.b_pb = 0; g.b_pn = (long)BM * ldb * 2;
    g.lda = lda; g.ldb = ldb; g.nt = K / BK; g.nM = nM; g.nN = nN; g.a_ks = 0; g.b_ks = 0; g.pn_mask = 0x7fffffff; g.pn_shift = 30; g.nsplit = 0; g.rev = 0; return g;
}
__device__ __forceinline__ GemmP mk_gemm_split(const bf16_t* A, int lda, const bf16_t* B, int ldb, int K) {
    GemmP g = mk_gemm(A + (size_t)MP * lda, lda, B, ldb, 256, 1, 4 * (K / 256));
    g.a_pn = 0; g.a_ks = 512; g.b_ks = 512; g.pn_mask = 3; g.pn_shift = 2; return g;
}

__device__ __forceinline__ void tr_item(const float* src, int sld, bf16_t* dst, int dld, int nvalid, LAS float* scr, int lane, bool late) {
    {
        const int n4 = (lane & 7) * 4; f32x4 v[8];
#pragma unroll
        for (int i = 0; i < 8; ++i) { const int kk = 8 * i + (lane >> 3); v[i] = (n4 < nvalid) ? __builtin_nontemporal_load((const f32x4*)(src + (size_t)kk * sld + n4)) : (f32x4){0.f, 0.f, 0.f, 0.f}; }
#pragma unroll
        for (int i = 0; i < 8; ++i) { const int kk = 8 * i + (lane >> 3); LAS float* d = scr + kk * 33 + n4; d[0] = v[i][0]; d[1] = v[i][1]; d[2] = v[i][2]; d[3] = v[i][3]; }
    }
    LDS_WAIT(); asm volatile("" ::: "memory");
    const int c = lane & 7;
#pragma unroll
    for (int j = 0; j < 4; ++j) { const int n = (lane >> 3) + 8 * j; const LAS float* s = scr + (8 * c) * 33 + n;
        u32x4 o; o.x = cvt_pk_bf16(s[0 * 33], s[1 * 33]); o.y = cvt_pk_bf16(s[2 * 33], s[3 * 33]); o.z = cvt_pk_bf16(s[4 * 33], s[5 * 33]); o.w = cvt_pk_bf16(s[6 * 33], s[7 * 33]);
        if (late) __builtin_nontemporal_store(o, (u32x4*)(dst + (size_t)n * dld + 8 * c));
        else *(u32x4*)(dst + (size_t)n * dld + 8 * c) = o; }
    LDS_WAIT(); asm volatile("" ::: "memory");
}

__device__ __noinline__ void prep_phase(ArgsP a, LAS unsigned char* lds) {
    const int tid = threadIdx.x, lane = tid & 63, wave = tid >> 6;
    unsigned char* ws = a->ws;
    LAS float* scr = (LAS float*)(lds + wave * 8704);
    const int gw = blockIdx.x * 8 + wave, NGW = gridDim.x * 8;
    bf16_t* Wgu = (bf16_t*)(ws + WS_WGU); bf16_t* Wdn = (bf16_t*)(ws + WS_WDN);
    constexpr int I_FFN = 4 * 4224, I_SQ = 512;
    constexpr int NITEMS = I_FFN + 8 * I_SQ + 1024 + 512 + 16 + 512 + 1024 + 512;
#pragma unroll 1
    for (int it = gw; it < NITEMS; it += NGW) {
        int r = it;
        const float* src; bf16_t* dst; int sld, dld, nvalid = 32; bool late = true;
        bf16_t* Wab = (bf16_t*)(ws + WS_WABIN);
        if (r < I_FFN) {
            const int ls = r / 4224; r %= 4224; const int which = r / 1408; r %= 1408; late = ls != 0;
            if (which < 2) { const int kb = r / 88, nb = r % 88, n0 = nb * 32, k0 = kb * 64;
                src = a->in[which == 0 ? 10 : 11] + (size_t)ls * 1024 * 2816 + (size_t)k0 * 2816 + n0; sld = 2816;
                const int drow = (n0 / 128) * 256 + which * 128 + (n0 % 128);
                dst = Wgu + ((size_t)ls * 5632 + drow) * 1024 + k0; dld = 1024;
            } else { const int kb = r / 32, nb = r % 32, n0 = nb * 32, k0 = kb * 64;
                src = a->in[12] + (size_t)ls * 2816 * 1024 + (size_t)k0 * 1024 + n0; sld = 1024;
                dst = Wdn + ((size_t)ls * 1024 + n0) * 2816 + k0; dld = 2816; }
        } else if ((r -= I_FFN) < 8 * I_SQ) {
            const int mat = r / 1024; r %= 1024; const int l = r / 512; r %= 512;
            const int kb = r / 32, nb = r % 32, n0 = nb * 32, k0 = kb * 64;
            src = a->in[13 + mat] + (size_t)l * 1024 * 1024 + (size_t)k0 * 1024 + n0; sld = 1024; dld = 1024;
            if (mat == 0) dst = (bf16_t*)(ws + WS_WQ) + ((size_t)l * 1024 + n0) * 1024 + k0;
            else if (mat == 3) dst = (bf16_t*)(ws + WS_WO) + ((size_t)l * 1024 + n0) * 1024 + k0;
            else { dst = (bf16_t*)(ws + WS_WKV) + ((size_t)(l * 2 + (mat - 1)) * 1024 + n0) * 1024 + k0; late = false; }
        } else if ((r -= 8 * I_SQ) < 1024) { const int kb = r / 64, nb = r % 64, n0 = nb * 32, k0 = kb * 64;
            src = a->in[17] + (size_t)k0 * 3080 + n0; sld = 3080; dst = Wab + (size_t)n0 * 1024 + k0; dld = 1024; late = false;
        } else if ((r -= 1024) < 512) { const int kb = r / 32, nb = r % 32, n0 = nb * 32, k0 = kb * 64;
            src = a->in[17] + (size_t)k0 * 3080 + 2056 + n0; sld = 3080; dst = Wab + (size_t)(2048 + n0) * 1024 + k0; dld = 1024; late = false;
        } else if ((r -= 512) < 16) { const int k0 = r * 64;
            src = a->in[17] + (size_t)k0 * 3080 + 2048; sld = 3080; dst = Wab + (size_t)3072 * 1024 + k0; dld = 1024; nvalid = 8; late = false;
        } else if ((r -= 16) < 512) { const int kb = r / 32, nb = r % 32, n0 = nb * 32, k0 = kb * 64;
            src = a->in[26] + (size_t)k0 * 1024 + n0; sld = 1024; dst = (bf16_t*)(ws + WS_WABOUT) + (size_t)n0 * 1024 + k0; dld = 1024;
        } else if ((r -= 512) < 1024) { const int kb = r / 64, nb = r % 64, n0 = nb * 32, k0 = kb * 64;
            src = a->in[27] + (size_t)k0 * 2048 + n0; sld = 2048; dst = (bf16_t*)(ws + WS_WGMIN) + (size_t)n0 * 1024 + k0; dld = 1024;
        } else { r -= 1024; const int kb = r / 32, nb = r % 32, n0 = nb * 32, k0 = kb * 64;
            src = a->in[32] + (size_t)k0 * 1024 + n0; sld = 1024; dst = (bf16_t*)(ws + WS_WGMOUT) + (size_t)n0 * 1024 + k0; dld = 1024; }
        tr_item(src, sld, dst, dld, nvalid, scr, lane, late);
    }
    bf16_t* XB = (bf16_t*)(ws + WS_XB); bf16_t* MEMB = (bf16_t*)(ws + WS_MEMB);
#pragma unroll 1
    for (int row = gw; row < MT + 2048; row += NGW) {
        if (row < MT) {
            const float* src = row < MP ? a->in[0] + (size_t)row * 1024 : a->in[1] + (size_t)(row - MP) * 1024;
#pragma unroll
            for (int j = 0; j < 4; ++j) { f32x4 v = (f32x4){0.f, 0.f, 0.f, 0.f}; if (row < MV) v = __builtin_nontemporal_load((const f32x4*)(src + (lane + 64 * j) * 4));
                u32x2 w; w.x = cvt_pk_bf16(v[0], v[1]); w.y = cvt_pk_bf16(v[2], v[3]); *(u32x2*)(XB + (size_t)row * 1024 + (lane + 64 * j) * 4) = w; }
        } else {
            const int mr = row - MT; const float* src = a->in[2] + (size_t)mr * 1024;
#pragma unroll
            for (int j = 0; j < 4; ++j) { const f32x4 v = __builtin_nontemporal_load((const f32x4*)(src + (lane + 64 * j) * 4));
                u32x2 w; w.x = cvt_pk_bf16(v[0], v[1]); w.y = cvt_pk_bf16(v[2], v[3]); *(u32x2*)(MEMB + (size_t)mr * 1024 + (lane + 64 * j) * 4) = w; }
        }
    }
    const size_t gt = (size_t)blockIdx.x * 512 + tid, NGT = (size_t)gridDim.x * 512;
    { u32x4* z = (u32x4*)((bf16_t*)(ws + WS_WABIN) + (size_t)3104 * 1024); const size_t n = (size_t)(ABN - 3104) * 1024 * 2 / 16;
      for (size_t i = gt; i < n; i += NGT) z[i] = (u32x4){0u, 0u, 0u, 0u}; }
    { u32x4* z = (u32x4*)(ws + WS_ROWSUM); const size_t n = (size_t)2 * MP * 4 * 4 / 16;
      for (size_t i = gt; i < n; i += NGT) z[i] = (u32x4){0u, 0u, 0u, 0u}; }
    { bf16_t* o = (bf16_t*)(ws + WS_WGMS);
      for (size_t i = gt; i < (size_t)4 * 128 * 128; i += NGT) { const int ii = (int)((i >> 7) & 127), jj = (int)(i & 127); o[i] = f2bf(jj <= ii ? a->in[30][i] : 0.f); } }
}

__device__ __forceinline__ void ln_row_finish(f32x4 (&v)[4], const f32x4 (&gv)[4], const f32x4 (&bv)[4], bf16_t* XB, float* yout, size_t row, int lane) {
    float s = 0.f;
#pragma unroll
    for (int j = 0; j < 4; ++j) s += (v[j][0] + v[j][1]) + (v[j][2] + v[j][3]);
    const float mean = wave_sum(s) * (1.f / 1024.f); float q = 0.f;
#pragma unroll
    for (int j = 0; j < 4; ++j) { v[j] = v[j] - mean; q += (v[j][0] * v[j][0] + v[j][1] * v[j][1]) + (v[j][2] * v[j][2] + v[j][3] * v[j][3]); }
    const float rstd = rsqrtf(wave_sum(q) * (1.f / 1024.f) + LN_EPS);
#pragma unroll
    for (int j = 0; j < 4; ++j) { const f32x4 o = v[j] * rstd * gv[j] + bv[j];
        u32x2 w; w.x = cvt_pk_bf16(o[0], o[1]); w.y = cvt_pk_bf16(o[2], o[3]); *(u32x2*)(XB + row * 1024 + (lane + 64 * j) * 4) = w;
        if (yout) __builtin_nontemporal_store(o, (f32x4*)(yout + row * 1024 + (lane + 64 * j) * 4)); }
}
__device__ __forceinline__ f32x4 ld_bf4(const bf16_t* p) { const u32x2 w = *(const u32x2*)p; return (f32x4){bflo(w.x), bfhi(w.x), bflo(w.y), bfhi(w.y)}; }
__device__ __noinline__ void ln_phase(ArgsP a, int l, int idx, bool final_out, int nsplit, float scale) {
    const int lane = threadIdx.x & 63, wave = threadIdx.x >> 6;
    const int gw = blockIdx.x * 8 + wave, NGW = gridDim.x * 8;
    const bf16_t* T = (const bf16_t*)(a->ws + WS_T); bf16_t* XB = (bf16_t*)(a->ws + WS_XB);
    float* yout = final_out ? a->out + O_Y : nullptr;
    const float* g = a->in[8] + (size_t)(l * 4 + idx) * 1024; const float* b = a->in[9] + (size_t)(l * 4 + idx) * 1024;
    f32x4 gv[4], bv[4];
#pragma unroll
    for (int j = 0; j < 4; ++j) { gv[j] = *(const f32x4*)(g + (lane + 64 * j) * 4); bv[j] = *(const f32x4*)(b + (lane + 64 * j) * 4); }
    for (int row = MP + gw; row < MV; row += NGW) {
        f32x4 v[4];
#pragma unroll
        for (int j = 0; j < 4; ++j) {
            f32x4 p = (f32x4){0.f, 0.f, 0.f, 0.f};
            for (int ks = 0; ks < nsplit; ++ks) p += *(const f32x4*)((const float*)(a->ws + WS_PART) + ((size_t)ks * 256 + (row - MP)) * 1024 + (lane + 64 * j) * 4);
            v[j] = ld_bf4(XB + (size_t)row * 1024 + (lane + 64 * j) * 4) * ALPHA + p * scale;
        }
        ln_row_finish(v, gv, bv, XB, yout, (size_t)row, lane);
    }
    for (int row = gw; row < MP; row += 2 * NGW) {
        const int row2 = row + NGW; const bool has2 = row2 < MP;
        f32x4 v0[4], v1[4];
#pragma unroll
        for (int j = 0; j < 4; ++j) v0[j] = ld_bf4(T + (size_t)row * 1024 + (lane + 64 * j) * 4);
#pragma unroll
        for (int j = 0; j < 4; ++j) v1[j] = has2 ? ld_bf4(T + (size_t)row2 * 1024 + (lane + 64 * j) * 4) : (f32x4){0.f, 0.f, 0.f, 0.f};
        ln_row_finish(v0, gv, bv, XB, yout, (size_t)row, lane);
        if (has2) ln_row_finish(v1, gv, bv, XB, yout, (size_t)row2, lane);
    }
}

constexpr int GST = 132;
__device__ __noinline__ void gdn_prep_item(ArgsP a, LAS unsigned char* lds, int item) {
    const int tid = threadIdx.x, lane = tid & 63, wave = tid >> 6;
    const int bh = item >> 5, n = item & 31, b = bh >> 2, h = bh & 3;
    const bf16_t* PROJ = (const bf16_t*)(a->ws + WS_WIDE);
    LAS float* qs = (LAS float*)lds; LAS float* ks = qs + 64 * GST; LAS float* vs = ks + 64 * GST; LAS float* Ms = vs + 64 * GST;
    LAS float* gc = Ms + 64 * 64; LAS float* bs = gc + 64; LAS float* eg = bs + 64;
    const size_t rowbase = (size_t)b * SEQ + (size_t)n * 64;
    {
        const int c = tid & 127, tq = tid >> 7;
#pragma unroll
        for (int seg = 0; seg < 3; ++seg) {
            const int col = seg * 512 + h * 128 + c;
            const float w0 = a->in[18][col], w1 = a->in[18][1536 + col], w2 = a->in[18][2 * 1536 + col], w3 = a->in[18][3 * 1536 + col];
            LAS float* dst = seg == 0 ? qs : (seg == 1 ? ks : vs);
            const int t0 = tq * 16;
            float x0 = 0.f, x1 = 0.f, x2 = 0.f;
            {
                const long tt = (long)n * 64 + t0;
                if (tt - 3 >= 0) x0 = bf2f(PROJ[(rowbase + t0 - 3) * ABN + col]);
                if (tt - 2 >= 0) x1 = bf2f(PROJ[(rowbase + t0 - 2) * ABN + col]);
                if (tt - 1 >= 0) x2 = bf2f(PROJ[(rowbase + t0 - 1) * ABN + col]);
            }
            bf16_t xr[16];
#pragma unroll
            for (int t = 0; t < 16; ++t) xr[t] = PROJ[(rowbase + t0 + t) * ABN + col];
#pragma unroll
            for (int t = 0; t < 16; ++t) {
                const float x3 = bf2f(xr[t]);
                const float y = w0 * x0 + w1 * x1 + w2 * x2 + w3 * x3;
                dst[(t0 + t) * GST + c] = siluf(y);
                x0 = x1; x1 = x2; x2 = x3;
            }
        }
        if (tid < 64) {
            const float braw = bf2f(PROJ[(rowbase + tid) * ABN + 3072 + h]);
            const float araw = bf2f(PROJ[(rowbase + tid) * ABN + 3076 + h]);
            const float xx = araw + a->in[20][h];
            const float sp = xx > 20.f ? xx : log1pf(__expf(xx));
            float gval = -__expf(a->in[19][h]) * sp;
            bs[tid] = sigmf(braw);
#pragma unroll
            for (int o = 1; o < 64; o <<= 1) { const float nb_ = __shfl_up(gval, o); if (lane >= o) gval += nb_; }
            gc[tid] = gval; eg[tid] = __expf(gval);
        }
    }
    __syncthreads();
    {
        LAS float* base = (wave < 4 ? qs : ks) + ((wave & 3) * 16) * GST;
        float x0[16], x1[16], ss[16];
#pragma unroll
        for (int r = 0; r < 16; ++r) { x0[r] = base[r * GST + lane]; x1[r] = base[r * GST + lane + 64]; ss[r] = x0[r] * x0[r] + x1[r] * x1[r]; }
#pragma unroll
        for (int o = 1; o < 64; o <<= 1)
#pragma unroll
            for (int r = 0; r < 16; ++r) ss[r] += __shfl_xor(ss[r], o);
        const float qsc = wave < 4 ? 0.08838834764831845f : 1.f;
#pragma unroll
        for (int r = 0; r < 16; ++r) { const float sc = rsqrtf(ss[r] + 1e-6f) * qsc; base[r * GST + lane] = x0[r] * sc; base[r * GST + lane + 64] = x1[r] * sc; }
    }
    __syncthreads();
    {
        const int i = tid >> 3, jg = tid & 7;
        float aM[8], aQ[8];
#pragma unroll
        for (int jj = 0; jj < 8; ++jj) { aM[jj] = 0.f; aQ[jj] = 0.f; }
        for (int d = 0; d < 128; d += 4) {
            const f32x4 ki = *(const LAS f32x4*)(ks + i * GST + d), qi = *(const LAS f32x4*)(qs + i * GST + d);
#pragma unroll
            for (int jj = 0; jj < 8; ++jj) {
                const f32x4 kj = *(const LAS f32x4*)(ks + (jg + 8 * jj) * GST + d);
                aM[jj] += (ki[0] * kj[0] + ki[1] * kj[1]) + (ki[2] * kj[2] + ki[3] * kj[3]);
                aQ[jj] += (qi[0] * kj[0] + qi[1] * kj[1]) + (qi[2] * kj[2] + qi[3] * kj[3]);
            }
        }
        const float gi = gc[i], bi = bs[i];
        bf16_t* QK = (bf16_t*)(a->ws + WS_GQK) + (size_t)item * 64 * 64;
#pragma unroll
        for (int jj = 0; jj < 8; ++jj) {
            const int j = jg + 8 * jj;
            const float dec = (j <= i) ? __expf(gi - gc[j]) : 0.f;
            Ms[i * 64 + j] = (j < i) ? bi * aM[jj] * dec : 0.f;
            QK[i * 64 + j] = f2bf(aQ[jj] * dec);
        }
    }
    __syncthreads();
    if (tid < 256) {
        const int c = tid & 127; const bool isw = tid >= 128;
        const LAS float* src = isw ? ks : vs;
        int vz; asm volatile("v_mov_b32 %0, 0" : "=v"(vz));
        const LAS float* Msv = Ms + vz;
        float x[64];
#pragma unroll
        for (int i = 0; i < 64; ++i) x[i] = 0.f;
        float* U = (float*)(a->ws + WS_GU) + (size_t)item * 64 * 128;
        bf16_t* W = (bf16_t*)(a->ws + WS_GW) + (size_t)item * 64 * 128;
#pragma unroll
        for (int i = 0; i < 64; ++i) {
            float acc = src[i * GST + c] * bs[i] * (isw ? eg[i] : 1.f);
#pragma unroll
            for (int j4 = 0; j4 < (i + 3) / 4; ++j4) {
                const f32x4 m = *(const LAS f32x4*)(Msv + i * 64 + j4 * 4);
                acc -= m[0] * x[j4 * 4 + 0]; acc -= m[1] * x[j4 * 4 + 1]; acc -= m[2] * x[j4 * 4 + 2]; acc -= m[3] * x[j4 * 4 + 3];
            }
            x[i] = acc;
            if (isw) W[i * 128 + c] = f2bf(acc); else U[i * 128 + c] = acc;
        }
    } else {
        const int t2 = tid - 256;
        bf16_t* QG = (bf16_t*)(a->ws + WS_GQG) + (size_t)item * 64 * 128;
        bf16_t* KTT = (bf16_t*)(a->ws + WS_GKTT) + (size_t)item * 128 * 64;
        const float glast = gc[63];
        for (int idx = t2; idx < 64 * 128; idx += 256) { const int i = idx >> 7, d = idx & 127; QG[idx] = f2bf(qs[i * GST + d] * eg[i]); }
        for (int idx = t2; idx < 128 * 64; idx += 256) { const int d = idx >> 6, i = idx & 63; KTT[idx] = f2bf(ks[i * GST + d] * __expf(glast - gc[i])); }
        if (t2 == 0) ((float*)(a->ws + WS_GGL))[(size_t)item * 32] = eg[63];
    }
    __syncthreads();
}

__device__ __noinline__ void gdn_sample_item(ArgsP a, LAS unsigned char* lds, int item) {
    const int tid = threadIdx.x, lane = tid & 63, wave = tid >> 6;
    const int b = item >> 2, h = item & 3;
    const bf16_t* PROJ = (const bf16_t*)(a->ws + WS_WIDE) + (size_t)(MP + b) * ABN;
    LAS float* qkv = (LAS float*)lds;
    LAS float* part = qkv + 384;
    LAS float* sc = part + 1024;
    if (tid < 384) {
        const int seg = tid >> 7, c = tid & 127, col = seg * 512 + h * 128 + c;
        const float* buf = a->in[6] + (size_t)b * 3 * 1536;
        const float xn = bf2f(PROJ[col]);
        const float b0 = buf[col], b1 = buf[1536 + col], b2 = buf[2 * 1536 + col];
        const float y = a->in[18][col] * b0 + a->in[18][1536 + col] * b1 + a->in[18][2 * 1536 + col] * b2 + a->in[18][3 * 1536 + col] * xn;
        qkv[tid] = siluf(y);
        float* o = a->out + O_DNC_S + (size_t)b * 3 * 1536;
        o[col] = b1; o[1536 + col] = b2; o[2 * 1536 + col] = xn;
    }
    if (tid == 384) {
        const float braw = bf2f(PROJ[3072 + h]), araw = bf2f(PROJ[3076 + h]);
        const float xx = araw + a->in[20][h]; const float sp = xx > 20.f ? xx : log1pf(__expf(xx));
        sc[1] = sigmf(braw); sc[2] = __expf(-__expf(a->in[19][h]) * sp);
    }
    __syncthreads();
    if (wave < 2) {
        LAS float* p = qkv + wave * 128; const float x0 = p[lane], x1 = p[lane + 64];
        const float ss = wave_sum(x0 * x0 + x1 * x1);
        const float s_ = rsqrtf(ss + 1e-6f) * (wave == 0 ? 0.08838834764831845f : 1.f);
        p[lane] = x0 * s_; p[lane + 64] = x1 * s_;
    }
    __syncthreads();
    if (wave == 0) { const float d = wave_sum(qkv[lane] * qkv[128 + lane] + qkv[lane + 64] * qkv[128 + lane + 64]); if (lane == 0) sc[0] = d; }
    const int e = tid & 127, dq = tid >> 7;
    const float* S0 = a->in[5] + ((size_t)item * 128 + dq * 32) * 128 + e;
    float S[32]; float pk = 0.f, pq = 0.f;
#pragma unroll
    for (int i = 0; i < 32; ++i) { S[i] = __builtin_nontemporal_load(S0 + (size_t)i * 128); }
#pragma unroll
    for (int i = 0; i < 32; ++i) { pk += qkv[128 + dq * 32 + i] * S[i]; pq += qkv[dq * 32 + i] * S[i]; }
    part[dq * 128 + e] = pk; part[512 + dq * 128 + e] = pq;
    __syncthreads();
    const float kS = (part[e] + part[128 + e]) + (part[256 + e] + part[384 + e]);
    const float qS = (part[512 + e] + part[640 + e]) + (part[768 + e] + part[896 + e]);
    const float beta = sc[1], egv = sc[2], qk = sc[0];
    const float vnew = beta * (qkv[256 + e] - egv * kS);
    float* So = a->out + O_DNS_S + ((size_t)item * 128 + dq * 32) * 128 + e;
#pragma unroll
    for (int i = 0; i < 32; ++i) __builtin_nontemporal_store(egv * S[i] + qkv[128 + dq * 32 + i] * vnew, So + (size_t)i * 128);
    if (dq == 0) ((float*)(a->ws + WS_ORAW))[(size_t)(MP + b) * 512 + h * 128 + e] = egv * qS + qk * vnew;
    __syncthreads();
}

__device__ __noinline__ void gdn_scan_item(ArgsP a, LAS unsigned char* lds, int item) {
    const int tid = threadIdx.x, lane = tid & 63, wave = __builtin_amdgcn_readfirstlane(tid >> 6);
    const int bh = item >> 3, sl = item & 7, b = bh >> 2, h = bh & 3, e0 = sl * 16;
    const int ln = lane & 15, kg = lane >> 4;
    LAS bf16_t* ST = (LAS bf16_t*)lds;
    LAS bf16_t* VN = (LAS bf16_t*)(lds + 16 * 136 * 2);
    const float* U = (const float*)(a->ws + WS_GU); const bf16_t* W = (const bf16_t*)(a->ws + WS_GW); const bf16_t* QG = (const bf16_t*)(a->ws + WS_GQG);
    const bf16_t* KTT = (const bf16_t*)(a->ws + WS_GKTT); const bf16_t* QK = (const bf16_t*)(a->ws + WS_GQK); const float* GL = (const float*)(a->ws + WS_GGL);
    float* ORAW = (float*)(a->ws + WS_ORAW);
    f32x4 S = (f32x4){0.f, 0.f, 0.f, 0.f};
    { u32x2 z; z.x = 0u; z.y = 0u; *(LAS u32x2*)(ST + ln * 136 + wave * 16 + kg * 4) = z; }
    __syncthreads();
#ifndef NCH
#define NCH 32
#endif
    for (int n = 0; n < NCH; ++n) {
        const size_t ci = (size_t)bh * 32 + n;
        bf16x8 aw[4], aq[4], aqk[2], akt[2]; f32x4 u = (f32x4){0.f, 0.f, 0.f, 0.f};
#pragma unroll
        for (int k2 = 0; k2 < 2; ++k2) akt[k2] = *(const bf16x8*)(KTT + ci * 8192 + (size_t)(wave * 16 + ln) * 64 + k2 * 32 + kg * 8);
        const float gl = GL[ci * 32];
        f32x4 qsacc = (f32x4){0.f, 0.f, 0.f, 0.f};
        if (wave < 4) {
#pragma unroll
            for (int k4 = 0; k4 < 4; ++k4) { aw[k4] = *(const bf16x8*)(W + ci * 8192 + (size_t)(wave * 16 + ln) * 128 + k4 * 32 + kg * 8);
                                             aq[k4] = *(const bf16x8*)(QG + ci * 8192 + (size_t)(wave * 16 + ln) * 128 + k4 * 32 + kg * 8); }
#pragma unroll
            for (int k2 = 0; k2 < 2; ++k2) aqk[k2] = *(const bf16x8*)(QK + ci * 4096 + (size_t)(wave * 16 + ln) * 64 + k2 * 32 + kg * 8);
#pragma unroll
            for (int j = 0; j < 4; ++j) u[j] = U[ci * 8192 + (size_t)(wave * 16 + kg * 4 + j) * 128 + e0 + ln];
            f32x4 wsacc = (f32x4){0.f, 0.f, 0.f, 0.f};
#pragma unroll
            for (int k4 = 0; k4 < 4; ++k4) {
                const bf16x8 bs_ = *(const LAS bf16x8*)(ST + ln * 136 + k4 * 32 + kg * 8);
                wsacc = __builtin_amdgcn_mfma_f32_16x16x32_bf16(aw[k4], bs_, wsacc, 0, 0, 0);
                qsacc = __builtin_amdgcn_mfma_f32_16x16x32_bf16(aq[k4], bs_, qsacc, 0, 0, 0);
            }
            const f32x4 vn = u - wsacc;
            u32x2 w2; w2.x = cvt_pk_bf16(vn[0], vn[1]); w2.y = cvt_pk_bf16(vn[2], vn[3]);
            *(LAS u32x2*)(VN + ln * 72 + wave * 16 + kg * 4) = w2;
        }
        __syncthreads();
        bf16x8 bv[2];
#pragma unroll
        for (int k2 = 0; k2 < 2; ++k2) bv[k2] = *(const LAS bf16x8*)(VN + ln * 72 + k2 * 32 + kg * 8);
        if (wave < 4) {
#pragma unroll
            for (int k2 = 0; k2 < 2; ++k2) qsacc = __builtin_amdgcn_mfma_f32_16x16x32_bf16(aqk[k2], bv[k2], qsacc, 0, 0, 0);
            const size_t tok = (size_t)b * SEQ + (size_t)n * 64 + wave * 16 + kg * 4;
#pragma unroll
            for (int j = 0; j < 4; ++j) ORAW[(tok + j) * 512 + h * 128 + e0 + ln] = qsacc[j];
        }
        S = S * gl;
#pragma unroll
        for (int k2 = 0; k2 < 2; ++k2) S = __builtin_amdgcn_mfma_f32_16x16x32_bf16(akt[k2], bv[k2], S, 0, 0, 0);
        { u32x2 w2; w2.x = cvt_pk_bf16(S[0], S[1]); w2.y = cvt_pk_bf16(S[2], S[3]); *(LAS u32x2*)(ST + ln * 136 + wave * 16 + kg * 4) = w2; }
        __syncthreads();
    }
    float* So = a->out + O_DNS_P + (size_t)bh * 128 * 128;
#pragma unroll
    for (int j = 0; j < 4; ++j) So[(size_t)(wave * 16 + kg * 4 + j) * 128 + e0 + ln] = S[j];
    __syncthreads();
}

__device__ __noinline__ void gdn_finish_phase(ArgsP a) {
    const int lane = threadIdx.x & 63, wave = threadIdx.x >> 6, sub = lane >> 4, l16 = lane & 15;
    const int gw = blockIdx.x * 8 + wave, NGW = gridDim.x * 8;
    const bf16_t* PROJ = (const bf16_t*)(a->ws + WS_WIDE); const float* ORAW = (const float*)(a->ws + WS_ORAW); bf16_t* OC = (bf16_t*)(a->ws + WS_OC);
    const f32x4 g0 = *(const f32x4*)(a->in[21] + l16 * 8), g1 = *(const f32x4*)(a->in[21] + l16 * 8 + 4);
    for (int p0 = gw * 4; p0 < MV * 4; p0 += NGW * 4) {
        const int p = p0 + sub; const size_t row = (size_t)(p >> 2); const int h = p & 3;
        const f32x4 o0 = *(const f32x4*)(ORAW + row * 512 + h * 128 + l16 * 8), o1 = *(const f32x4*)(ORAW + row * 512 + h * 128 + l16 * 8 + 4);
        const u32x4 zw = *(const u32x4*)(PROJ + row * ABN + 1536 + h * 128 + l16 * 8);
        float ss = (o0[0] * o0[0] + o0[1] * o0[1]) + (o0[2] * o0[2] + o0[3] * o0[3]) + (o1[0] * o1[0] + o1[1] * o1[1]) + (o1[2] * o1[2] + o1[3] * o1[3]);
        ss += __shfl_xor(ss, 1); ss += __shfl_xor(ss, 2); ss += __shfl_xor(ss, 4); ss += __shfl_xor(ss, 8);
        const float r = rsqrtf(ss * (1.f / 128.f) + 1e-6f);
        u32x4 w;
        w.x = cvt_pk_bf16(o0[0] * r * g0[0] * siluf(bflo(zw.x)), o0[1] * r * g0[1] * siluf(bfhi(zw.x)));
        w.y = cvt_pk_bf16(o0[2] * r * g0[2] * siluf(bflo(zw.y)), o0[3] * r * g0[3] * siluf(bfhi(zw.y)));
        w.z = cvt_pk_bf16(o1[0] * r * g1[0] * siluf(bflo(zw.z)), o1[1] * r * g1[1] * siluf(bfhi(zw.z)));
        w.w = cvt_pk_bf16(o1[2] * r * g1[2] * siluf(bflo(zw.w)), o1[3] * r * g1[3] * siluf(bfhi(zw.w)));
        *(u32x4*)(OC + row * 1024 + h * 128 + l16 * 8) = w;
    }
}

__device__ __noinline__ void conf_item(ArgsP a, LAS unsigned char* lds, int item) {
    const int tid = threadIdx.x, lane = tid & 63, wave = tid >> 6;
    const int b = item >> 6, tt = item & 63, t0 = tt * 32;
    const bf16_t* PROJ = (const bf16_t*)(a->ws + WS_WIDE); bf16_t* OC = (bf16_t*)(a->ws + WS_OC);
    LAS float* G = (LAS float*)lds;
    const int ch = tid;
    for (int r0 = 0; r0 < 64; r0 += 8) {
        bf16_t ga[8], gb[8];
#pragma unroll
        for (int k = 0; k < 8; ++k) { const int r = r0 + k, t = t0 - 30 + r; ga[k] = 0; gb[k] = 0;
            if (r < 62 && t >= 0) { const size_t row = (size_t)b * SEQ + t; ga[k] = PROJ[row * ABN + 2048 + ch]; gb[k] = PROJ[row * ABN + 2560 + ch]; } }
#pragma unroll
        for (int k = 0; k < 8; ++k) { const int r = r0 + k;
            if (r < 62) { const float v = bf2f(ga[k]) * sigmf(bf2f(gb[k]));
                G[r * 512 + ch] = v;
                if (tt == 63 && r >= 32) a->out[O_CCC_P + ((size_t)b * 30 + (r - 32)) * 512 + ch] = v; } }
    }
    if (tt == 63) {
        for (int idx = tid; idx < 3 * 1536; idx += 512) { const int rr = idx / 1536, col = idx % 1536;
            a->out[O_DNC_P + (size_t)b * 3 * 1536 + idx] = bf2f(PROJ[((size_t)b * SEQ + 2045 + rr) * ABN + col]); }
    }
    float w[31];
#pragma unroll
    for (int i = 0; i < 31; ++i) w[i] = a->in[22][i * 512 + ch];
    const float bias = a->in[23][ch];
    __syncthreads();
    float co[32];
#pragma unroll
    for (int t = 0; t < 32; ++t) {
        float acc = bias;
#pragma unroll
        for (int i = 0; i < 31; ++i) acc += w[i] * G[(t + i) * 512 + ch];
        co[t] = acc;
    }
    __syncthreads();
#pragma unroll
    for (int t = 0; t < 32; ++t) G[t * 512 + ch] = co[t];
    __syncthreads();
    for (int t = wave * 4; t < wave * 4 + 4; ++t) {
        float v[8]; float s = 0.f;
#pragma unroll
        for (int k = 0; k < 8; ++k) { v[k] = G[t * 512 + lane + 64 * k]; s += v[k]; }
        const float mean = wave_sum(s) * (1.f / 512.f); float q = 0.f;
#pragma unroll
        for (int k = 0; k < 8; ++k) { v[k] -= mean; q += v[k] * v[k]; }
        const float rstd = rsqrtf(wave_sum(q) * (1.f / 512.f) + LN_EPS);
        const size_t row = (size_t)b * SEQ + t0 + t;
#pragma unroll
        for (int k = 0; k < 8; ++k) { const int c = lane + 64 * k; OC[row * 1024 + 512 + c] = f2bf(siluf(v[k] * rstd * a->in[24][c] + a->in[25][c])); }
    }
    __syncthreads();
}

__device__ __noinline__ void conf_sample_item(ArgsP a, LAS unsigned char* lds, int b) {
    const int tid = threadIdx.x, lane = tid & 63, wave = tid >> 6;
    const bf16_t* PROJ = (const bf16_t*)(a->ws + WS_WIDE) + (size_t)(MP + b) * ABN; bf16_t* OC = (bf16_t*)(a->ws + WS_OC);
    LAS float* red = (LAS float*)lds;
    const int ch = tid;
    const float* buf = a->in[7] + (size_t)b * 30 * 512;
    float* ob = a->out + O_CCC_S + (size_t)b * 30 * 512;
    const float gnew = bf2f(PROJ[2048 + ch]) * sigmf(bf2f(PROJ[2560 + ch]));
    float acc = a->in[23][ch] + a->in[22][30 * 512 + ch] * gnew;
    for (int i = 0; i < 30; ++i) { const float v = buf[i * 512 + ch]; acc += a->in[22][i * 512 + ch] * v; if (i >= 1) ob[(i - 1) * 512 + ch] = v; }
    ob[29 * 512 + ch] = gnew;
    float s = wave_sum(acc); if (lane == 0) red[wave] = s;
    __syncthreads();
    float tot = 0.f;
#pragma unroll
    for (int k = 0; k < 8; ++k) tot += red[k];
    const float mean = tot * (1.f / 512.f); const float dv = acc - mean;
    float q = wave_sum(dv * dv); if (lane == 0) red[8 + wave] = q;
    __syncthreads();
    float tq = 0.f;
#pragma unroll
    for (int k = 0; k < 8; ++k) tq += red[8 + k];
    const float rstd = rsqrtf(tq * (1.f / 512.f) + LN_EPS);
    OC[(size_t)(MP + b) * 1024 + 512 + ch] = f2bf(siluf(dv * rstd * a->in[24][ch] + a->in[25][ch]));
    __syncthreads();
}

__device__ __noinline__ void gm_ln_phase(ArgsP a) {
    const int lane = threadIdx.x & 63, wave = threadIdx.x >> 6;
    const int gw = blockIdx.x * 8 + wave, NGW = gridDim.x * 8;
    const bf16_t* PR = (const bf16_t*)(a->ws + WS_WIDE); bf16_t* VLN = (bf16_t*)(a->ws + WS_QB); bf16_t* OC = (bf16_t*)(a->ws + WS_OC);
    for (int row = gw; row < MV; row += NGW) {
        float v[16]; float s = 0.f;
#pragma unroll
        for (int j = 0; j < 2; ++j) { const u32x4 w = *(const u32x4*)(PR + (size_t)row * 2048 + 1024 + (lane + 64 * j) * 8);
            v[j * 8 + 0] = bflo(w.x); v[j * 8 + 1] = bfhi(w.x); v[j * 8 + 2] = bflo(w.y); v[j * 8 + 3] = bfhi(w.y);
            v[j * 8 + 4] = bflo(w.z); v[j * 8 + 5] = bfhi(w.z); v[j * 8 + 6] = bflo(w.w); v[j * 8 + 7] = bfhi(w.w); }
#pragma unroll
        for (int k = 0; k < 16; ++k) s += v[k];
        const float mean = wave_sum(s) * (1.f / 1024.f); float q = 0.f;
#pragma unroll
        for (int k = 0; k < 16; ++k) { v[k] -= mean; q += v[k] * v[k]; }
        const float rstd = rsqrtf(wave_sum(q) * (1.f / 1024.f) + LN_EPS);
#pragma unroll
        for (int j = 0; j < 2; ++j) {
            const int c0 = (lane + 64 * j) * 8; float o[8];
#pragma unroll
            for (int k = 0; k < 8; ++k) o[k] = v[j * 8 + k] * rstd * a->in[28][c0 + k] + a->in[29][c0 + k];
            u32x4 w; w.x = cvt_pk_bf16(o[0], o[1]); w.y = cvt_pk_bf16(o[2], o[3]); w.z = cvt_pk_bf16(o[4], o[5]); w.w = cvt_pk_bf16(o[6], o[7]);
            *(u32x4*)(VLN + (size_t)row * 1024 + c0) = w;
            if (row >= MP) {
                const int gi = c0 >> 8;
                const float ws0 = a->in[30][(size_t)gi * 128 * 128], bs0 = a->in[31][gi * 128];
                const u32x4 uw = *(const u32x4*)(PR + (size_t)row * 2048 + c0);
                float uu[8] = {bflo(uw.x), bfhi(uw.x), bflo(uw.y), bfhi(uw.y), bflo(uw.z), bfhi(uw.z), bflo(uw.w), bfhi(uw.w)};
                float f[8];
#pragma unroll
                for (int k = 0; k < 8; ++k) { a->out[O_GMV_S + (size_t)(row - MP) * 1024 + c0 + k] = o[k]; f[k] = uu[k] * (ws0 * o[k] + bs0); }
                u32x4 w2; w2.x = cvt_pk_bf16(f[0], f[1]); w2.y = cvt_pk_bf16(f[2], f[3]); w2.z = cvt_pk_bf16(f[4], f[5]); w2.w = cvt_pk_bf16(f[6], f[7]);
                *(u32x4*)(OC + (size_t)row * 1024 + c0) = w2;
            }
        }
    }
}

__device__ __noinline__ void gm_mix_item(ArgsP a, LAS unsigned char* lds, int item) {
    const int tid = threadIdx.x, lane = tid & 63, wave = __builtin_amdgcn_readfirstlane(tid >> 6);
    const int ck = item >> 4, sl = item & 15, gi = sl >> 2, c0 = sl * 64;
    const int ln = lane & 15, kg = lane >> 4;
    const bf16_t* VLN = (const bf16_t*)(a->ws + WS_QB); const bf16_t* PR = (const bf16_t*)(a->ws + WS_WIDE); bf16_t* OC = (bf16_t*)(a->ws + WS_OC);
    const bf16_t* WS_ = (const bf16_t*)(a->ws + WS_WGMS) + (size_t)gi * 128 * 128;
    LAS bf16_t* VTl = (LAS bf16_t*)lds;
    const size_t row0 = (size_t)ck * 128;
#pragma unroll
    for (int i = 0; i < 2; ++i) {
        const int q = tid + 512 * i, j = q >> 3, c8 = q & 7;
        const u32x4 w = *(const u32x4*)(VLN + (row0 + j) * 1024 + c0 + c8 * 8);
        LAS bf16_t* d = VTl + (c8 * 8) * 136 + j;
        d[0 * 136] = (bf16_t)(w.x & 0xffff); d[1 * 136] = (bf16_t)(w.x >> 16); d[2 * 136] = (bf16_t)(w.y & 0xffff); d[3 * 136] = (bf16_t)(w.y >> 16);
        d[4 * 136] = (bf16_t)(w.z & 0xffff); d[5 * 136] = (bf16_t)(w.z >> 16); d[6 * 136] = (bf16_t)(w.w & 0xffff); d[7 * 136] = (bf16_t)(w.w >> 16);
    }
    __syncthreads();
    f32x4 acc[4];
#pragma unroll
    for (int cb = 0; cb < 4; ++cb) acc[cb] = (f32x4){0.f, 0.f, 0.f, 0.f};
    const int ksmax = (wave * 16 + 15) >> 5;
    for (int k4 = 0; k4 <= ksmax; ++k4) {
        const bf16x8 af = *(const bf16x8*)(WS_ + (size_t)(wave * 16 + ln) * 128 + k4 * 32 + kg * 8);
#pragma unroll
        for (int cb = 0; cb < 4; ++cb) {
            const bf16x8 bf_ = *(const LAS bf16x8*)(VTl + (cb * 16 + ln) * 136 + k4 * 32 + kg * 8);
            acc[cb] = __builtin_amdgcn_mfma_f32_16x16x32_bf16(af, bf_, acc[cb], 0, 0, 0);
        }
    }
#pragma unroll
    for (int j = 0; j < 4; ++j) {
        const int i = wave * 16 + kg * 4 + j; const float bsv = a->in[31][gi * 128 + i];
#pragma unroll
        for (int cb = 0; cb < 4; ++cb) {
            const int c = c0 + cb * 16 + ln;
            const float u = bf2f(PR[(row0 + i) * 2048 + c]);
            OC[(row0 + i) * 1024 + c] = f2bf(u * (acc[cb][j] + bsv));
        }
    }
    __syncthreads();
}

__device__ __noinline__ void xattn_sample_item(ArgsP a, LAS unsigned char* lds, int l, int item) {
    const int tid = threadIdx.x, lane = tid & 63, wave = tid >> 6;
    const int b = item >> 2, h = item & 3;
    bf16_t* OC = (bf16_t*)(a->ws + WS_OC);
    const float* Kc = a->in[3] + ((size_t)(l * 128 + b) * 256) * 1024 + h * 256;
    const float* Vc = a->in[4] + ((size_t)(l * 128 + b) * 256) * 1024 + h * 256;
    LAS float* sc = (LAS float*)lds;
    LAS float* red = sc + 256;
    LAS float* op = red + 16;
    f32x4 q = (f32x4){0.f, 0.f, 0.f, 0.f};
#pragma unroll
    for (int ks = 0; ks < 4; ++ks) q += *(const f32x4*)((const float*)(a->ws + WS_PART) + ((size_t)ks * 256 + b) * 1024 + h * 256 + lane * 4);
    float mx = -1e30f;
#pragma unroll 1
    for (int i0 = 0; i0 < 32; i0 += 8) {
        float sv[8];
#pragma unroll
        for (int i = 0; i < 8; ++i) { const f32x4 k = __builtin_nontemporal_load((const f32x4*)(Kc + (size_t)(wave * 32 + i0 + i) * 1024 + lane * 4));
            sv[i] = (q[0] * k[0] + q[1] * k[1]) + (q[2] * k[2] + q[3] * k[3]); }
#pragma unroll
        for (int i = 0; i < 8; ++i) { const float sres = wave_sum(sv[i]) * 0.0625f; mx = fmaxf(mx, sres); if (lane == 0) sc[wave * 32 + i0 + i] = sres; }
    }
    if (lane == 0) red[wave] = mx;
    __syncthreads();
    float gmx = red[0];
#pragma unroll
    for (int k = 1; k < 8; ++k) gmx = fmaxf(gmx, red[k]);
    float psum = 0.f; f32x4 o = (f32x4){0.f, 0.f, 0.f, 0.f};
#pragma unroll 1
    for (int i0 = 0; i0 < 32; i0 += 8) {
        f32x4 vv[8];
#pragma unroll
        for (int i = 0; i < 8; ++i) vv[i] = __builtin_nontemporal_load((const f32x4*)(Vc + (size_t)(wave * 32 + i0 + i) * 1024 + lane * 4));
#pragma unroll
        for (int i = 0; i < 8; ++i) { const float p = __expf(sc[wave * 32 + i0 + i] - gmx); psum += p; o += vv[i] * p; }
    }
    if (lane == 0) red[8 + wave] = psum;
    *(LAS f32x4*)(op + wave * 256 + lane * 4) = o;
    __syncthreads();
    if (tid < 256) {
        float tot = 0.f, ov = 0.f;
#pragma unroll
        for (int k = 0; k < 8; ++k) { tot += red[8 + k]; ov += op[k * 256 + tid]; }
        OC[(size_t)(MP + b) * 1024 + h * 256 + tid] = f2bf(ov / tot);
    }
    __syncthreads();
}


#define XB_TMO      128
#define XB_XCNT(j)  (256  + 64 * (j))
#define XB_XSUB(j)  (1280 + 64 * (j))
#define XB_XGEN(j)  (2304 + 64 * (j))
#define XB_TOP      3328
#define XB_TOPGEN   3392
#define XCD_BAR_WORDS 3456
#define XB_SPIN_CAP (1u << 20)
__device__ __forceinline__ unsigned xb_ld(unsigned* p)              { return __hip_atomic_load(p, __ATOMIC_RELAXED, __HIP_MEMORY_SCOPE_AGENT); }
__device__ __forceinline__ unsigned xb_add(unsigned* p, unsigned v) { return __hip_atomic_fetch_add(p, v, __ATOMIC_RELAXED, __HIP_MEMORY_SCOPE_AGENT); }
__device__ __forceinline__ unsigned xb_xcc_id() { return (unsigned)__builtin_amdgcn_s_getreg((3 << 11) | 20) & 0xFu; }
#define XB_SPIN(cond, bar) do { unsigned _sp = 0; while (cond) { __builtin_amdgcn_s_sleep(1); \
    if ((++_sp & 255u) == 0u) { if (xb_ld(&(bar)[XB_TMO])) break; if (_sp > XB_SPIN_CAP) { atomicAdd(&(bar)[XB_TMO], 1u); break; } } } } while (0)
struct XcdBarrier { unsigned* bar; unsigned x; volatile LAS unsigned* st; };
__device__ __forceinline__ XcdBarrier xcd_barrier_post(unsigned* bar, volatile LAS unsigned* st) {
    XcdBarrier b; b.bar = bar; b.x = xb_xcc_id(); b.st = st;
    if (threadIdx.x == 0) (void)xb_add(&bar[XB_XCNT(b.x)], 1u);
    return b;
}
__device__ __forceinline__ void xcd_barrier_complete(unsigned* bar, unsigned x, unsigned& nloc, unsigned& nx) {
    const unsigned G = gridDim.x * gridDim.y * gridDim.z;
    unsigned sum, cnt, mine, sp = 0u;
    for (;;) {
        sum = 0u; cnt = 0u; mine = 0u;
#pragma unroll
        for (unsigned j = 0; j < 16; ++j) { const unsigned c = xb_ld(&bar[XB_XCNT(j)]); sum += c; cnt += (c > 0u) ? 1u : 0u; mine = (j == x) ? c : mine; }
        if (sum == G) break;
        __builtin_amdgcn_s_sleep(1);
        if ((++sp & 255u) == 0u) { if (xb_ld(&bar[XB_TMO])) break; if (sp > XB_SPIN_CAP) { atomicAdd(&bar[XB_TMO], 1u); break; } }
    }
    nloc = mine > 0u ? mine : 1u; nx = cnt > 0u ? cnt : 1u;
}
__device__ __forceinline__ void xcd_barrier(const XcdBarrier& b) {
    asm volatile("s_waitcnt vmcnt(0)" ::: "memory");
    __syncthreads();
    if (threadIdx.x == 0) {
        unsigned* bar = b.bar;
        __builtin_amdgcn_s_waitcnt(0);
        unsigned nloc = b.st[0], nx = b.st[1];
        if (nloc == 0u) { xcd_barrier_complete(bar, b.x, nloc, nx); b.st[0] = nloc; b.st[1] = nx; }
        const unsigned old = xb_add(&bar[XB_XSUB(b.x)], 1u);
        const unsigned gen = old / nloc;
        if (old + 1u == (gen + 1u) * nloc) {
            __builtin_amdgcn_fence(__ATOMIC_RELEASE, "agent");
            asm volatile("s_waitcnt vmcnt(0)" ::: "memory");
            const unsigned og = xb_add(&bar[XB_TOP], 1u);
            const unsigned tg = og / nx;
            if (og + 1u == (tg + 1u) * nx) xb_add(&bar[XB_TOPGEN], 1u);
            else XB_SPIN(xb_ld(&bar[XB_TOPGEN]) == tg, bar);
            __builtin_amdgcn_fence(__ATOMIC_ACQUIRE, "agent");
            xb_add(&bar[XB_XGEN(b.x)], 1u);
            asm volatile("s_waitcnt vmcnt(0)" ::: "memory");
        } else {
            XB_SPIN(xb_ld(&bar[XB_XGEN(b.x)]) == gen, bar);
            __builtin_amdgcn_fence(__ATOMIC_ACQUIRE, "agent");
            asm volatile("s_waitcnt vmcnt(0)" ::: "memory");
        }
    }
    __syncthreads();
}

__global__ void __launch_bounds__(512, 2) fwd_kernel(Args a_) {
    extern __shared__ __attribute__((aligned(16))) unsigned char lds_raw[];
    LAS unsigned char* lds = (LAS unsigned char*)lds_raw;
    cg::grid_group grid = cg::this_grid();
    const int G = gridDim.x, bx = blockIdx.x;
    const int ph_lo = a_.ph_lo, ph_hi = a_.ph_hi;
    int rep_done = 0; (void)rep_done;
    volatile LAS unsigned* bst = (volatile LAS unsigned*)(lds + LDS_STAGE);
    if (threadIdx.x < 2) bst[threadIdx.x] = 0u;
    __syncthreads();
    const XcdBarrier xb = xcd_barrier_post((unsigned*)(a_.ws + WS_BAR), bst);
    if (ph_lo < 0) grid.sync();
    for (int ph = ph_lo; ph < ph_hi; ++ph) {
        ArgsP a = (ArgsP)__builtin_amdgcn_kernarg_segment_ptr();
        asm volatile("" : "+s"(a));
        unsigned char* ws = a->ws;
        bf16_t* XB = (bf16_t*)(ws + WS_XB); bf16_t* WIDE = (bf16_t*)(ws + WS_WIDE); bf16_t* OC = (bf16_t*)(ws + WS_OC);
        bf16_t* QB = (bf16_t*)(ws + WS_QB); bf16_t* PB = (bf16_t*)(ws + WS_PB);
        float* T = (float*)(ws + WS_T); float* XRES = (float*)(ws + WS_XRES);
        if (ph == 0) { prep_phase(a, lds); }
        else {
            const int l = (ph - 1) / 17 >= 1 ? 1 : 0;
            const int q = ph - 1 - l * 17;
            int code;
            if (l == 0) code = q; else code = q < 3 ? q : (q < 8 ? 100 + (q - 3) : q + 1);
            EpiA e{};
            if (code == 0 || code == 14) {
                const int ls = l * 2 + (code == 14 ? 1 : 0);
                if (ph == 1) {
                    GemmP g = mk_gemm(ws + WS_MEMB, 1024, ws + WS_WKV, 1024, 1024, 8, 16); g.rev = 1;
                    EpiA ek{}; ek.f0 = a->out; ek.b0 = (bf16_t*)(ws + WS_KB); ek.b1 = (bf16_t*)(ws + WS_VT);
                    gemm_phase<EPI_KV>(lds, g, ek);
                }
                GemmP g = mk_gemm(XB, 1024, (bf16_t*)(ws + WS_WGU) + (size_t)ls * 5632 * 1024, 1024, 1024, MT / BM, 22);
                e.b0 = WIDE; e.ldc = FF;
                gemm_phase<EPI_SWIGLU>(lds, g, e);
            } else if (code == 1 || code == 15) {
                const int ls = l * 2 + (code == 15 ? 1 : 0);
                const bf16_t* Wd = (bf16_t*)(ws + WS_WDN) + (size_t)ls * 1024 * 2816;
                GemmP g = mk_gemm(WIDE, FF, Wd, FF, FF, MP / BM, 4);
                e.b0 = (bf16_t*)T; e.b1 = XB; e.s0 = ALPHA; e.s1 = 0.5f; e.f0 = (float*)(ws + WS_PART); g.nsplit = 11;
                gemm_phase<EPI_RES>(lds, g, e);
            } else if (code == 2) { ln_phase(a, l, 0, false, 11, 0.5f); }
            else if (code == 16) { ln_phase(a, l, 3, l == 1, 11, 0.5f); }
            else if (code == 8 || code == 104) { ln_phase(a, l, 1, false, 4, 1.f); }
            else if (code == 13) { ln_phase(a, l, 2, false, 4, 1.f); }
            else if (code == 3) {
                GemmP g = mk_gemm(XB, 1024, ws + WS_WABIN, 1024, 1024, MT / BM, ABN / BM);
                e.b0 = WIDE; e.ldc = ABN; e.flag = 0;
                gemm_phase<EPI_BF16>(lds, g, e);
            } else if (code == 4) {
                for (int it = bx; it < 1024; it += G) gdn_prep_item(a, lds, it);
                for (int it = bx; it < 512; it += G) gdn_sample_item(a, lds, it);
            } else if (code == 5) {
                for (int it = bx; it < 256; it += G) { int item = it; if (G == 256) { const int xcd = it & 7, k = it >> 3; item = (((k >> 3) * 8 + xcd) << 3) | (k & 7); } gdn_scan_item(a, lds, item); }
            } else if (code == 6) {
                for (int it = bx; it < 512; it += G) conf_item(a, lds, it);
                for (int it = bx; it < 128; it += G) conf_sample_item(a, lds, it);
                gdn_finish_phase(a);
            } else if (code == 7) {
                GemmP g = mk_gemm(OC, 1024, ws + WS_WABOUT, 1024, 1024, MP / BM, 4);
                e.b0 = (bf16_t*)T; e.b1 = XB; e.s0 = ALPHA; e.s1 = 1.f; e.f0 = (float*)(ws + WS_PART); g.nsplit = 4;
                gemm_phase<EPI_RES>(lds, g, e);
            } else if (code == 100) {
                GemmP g = mk_gemm(XB, 1024, ws + WS_WGMIN, 1024, 1024, MT / BM, 8);
                e.b0 = WIDE; e.ldc = 2048; e.flag = 1;
                gemm_phase<EPI_BF16>(lds, g, e);
            } else if (code == 101) { gm_ln_phase(a); }
            else if (code == 102) { for (int it = bx; it < 128 * 16; it += G) gm_mix_item(a, lds, it); }
            else if (code == 103) {
                GemmP g = mk_gemm(OC, 1024, ws + WS_WGMOUT, 1024, 1024, MP / BM, 4);
                e.b0 = (bf16_t*)T; e.b1 = XB; e.s0 = ALPHA; e.s1 = 1.f; e.f0 = (float*)(ws + WS_PART); g.nsplit = 4;
                gemm_phase<EPI_RES>(lds, g, e);
            } else if (code == 9) {
                const bf16_t* Wq = (bf16_t*)(ws + WS_WQ) + (size_t)l * 1024 * 1024;
                GemmP g = mk_gemm(XB, 1024, Wq, 1024, 1024, MP / BM, 4);
                e.b0 = QB; e.ldc = 1024; e.flag = 0; e.f0 = (float*)(ws + WS_PART); g.nsplit = 4;
                gemm_phase<EPI_BF16>(lds, g, e);
            } else if (code == 10) {
                GemmP g = mk_gemm(QB, 1024, ws + WS_KB, 1024, 256, 64, 4); g.A = (const char*)QB; g.B = (const char*)((bf16_t*)(ws + WS_KB) + (size_t)l * 8 * 256 * 1024);
                g.a_pm = (long)256 * 1024 * 2; g.a_pn = 256 * 2; g.b_pb = (long)256 * 1024 * 2; g.b_pn = 256 * 2; g.lda = 1024; g.ldb = 1024; g.nt = 4; g.nM = 64; g.nN = 4;
                e.b0 = PB; e.f0 = (float*)(ws + WS_ROWSUM) + (size_t)l * MP * 4;
                gemm_phase<EPI_SCORES>(lds, g, e);
                for (int it = bx; it < 512; it += G) xattn_sample_item(a, lds, l, it);
#if defined(DUP_CLASS) && DUP_CLASS == 8
                for (int it = bx; it < 512; it += G) xattn_sample_item(a, lds, l, it);
#endif
            } else if (code == 11) {
                GemmP g = mk_gemm(PB, 1024, ws + WS_VT, 256, 256, 64, 4); g.A = (const char*)PB; g.B = (const char*)((bf16_t*)(ws + WS_VT) + (size_t)l * 8 * 1024 * 256);
                g.a_pm = (long)256 * 1024 * 2; g.a_pn = 256 * 2; g.b_pb = (long)1024 * 256 * 2; g.b_pn = (long)256 * 256 * 2; g.lda = 1024; g.ldb = 256; g.nt = 4; g.nM = 64; g.nN = 4;
                e.b0 = OC; e.f1 = (const float*)(ws + WS_ROWSUM) + (size_t)l * MP * 4;
                gemm_phase<EPI_PV>(lds, g, e);
            } else if (code == 12) {
                const bf16_t* Wo = (bf16_t*)(ws + WS_WO) + (size_t)l * 1024 * 1024;
                GemmP g = mk_gemm(OC, 1024, Wo, 1024, 1024, MP / BM, 4);
                e.b0 = (bf16_t*)T; e.b1 = XB; e.s0 = ALPHA; e.s1 = 1.f; e.f0 = (float*)(ws + WS_PART); g.nsplit = 4;
                gemm_phase<EPI_RES>(lds, g, e);
            }
        }
#ifdef DUP_CLASS
        {
            int code_ = -1;
            if (ph > 0) { const int l_ = (ph - 1) / 17 >= 1 ? 1 : 0, q_ = ph - 1 - l_ * 17; code_ = l_ == 0 ? q_ : (q_ < 3 ? q_ : (q_ < 8 ? 100 + (q_ - 3) : q_ + 1)); }
            bool dup = false;
            if (DUP_CLASS == 1) dup = (code_ == 0 || code_ == 1 || code_ == 3 || code_ == 7 || code_ == 9 || code_ == 11 || code_ == 12 || code_ == 14 || code_ == 15 || code_ == 100 || code_ == 103);
            if (DUP_CLASS == 2) dup = (ph == 0 || code_ == 2 || code_ == 8 || code_ == 13 || code_ == 16 || code_ == 104 || code_ == 101);
            if (DUP_CLASS == 3) dup = (code_ == 4 || code_ == 5 || code_ == 6 || code_ == 102);
            if (DUP_CLASS == 4) dup = (code_ == 5);
            if (DUP_CLASS == 5) dup = (ph == 0);
            if (DUP_CLASS == 6) dup = (code_ == 4);
            if (DUP_CLASS == 9) dup = (code_ == 6);
            if (DUP_CLASS == 11) dup = (code_ == 0 || code_ == 14);
            if (DUP_CLASS == 12) dup = (code_ == 1 || code_ == 15);
            if (DUP_CLASS == 13) dup = (code_ == 7 || code_ == 103 || code_ == 12 || code_ == 9);
            if (DUP_CLASS == 10) dup = (code_ == 102 || code_ == 101);
            if (dup && !rep_done) { rep_done = 1; --ph; continue; }
            rep_done = 0;
        }
#endif
        if (ph + 1 < ph_hi) xcd_barrier(xb);
#if defined(DUP_CLASS) && DUP_CLASS == 7
        if (ph + 1 < ph_hi) xcd_barrier(xb);
#endif
    }
#ifdef DIAG_HI
    {
        grid.sync();
        ArgsP a = (ArgsP)__builtin_amdgcn_kernarg_segment_ptr();
        const float* XR = (const float*)(a->ws + WS_XRES); float* o = a->out;
        for (size_t i = (size_t)blockIdx.x * 512 + threadIdx.x; i < (size_t)MV * 1024; i += (size_t)gridDim.x * 512) { float vv = (i < (size_t)8 * 4 * 128 * 128) ? a->out[O_DNS_P + i] * 1000.37f : 0.f; o[i] = vv - floorf(vv); }
    }
#endif
}

extern "C" void kernel_launch(void* const* d_in, const int* in_sizes, int n_in, void* d_out, int out_size, void* d_ws, size_t ws_size, hipStream_t stream) {
    static int grid = 0;
    if (grid == 0) {
        if (n_in != 33 || (size_t)out_size != O_END || ws_size < WS_END) { fprintf(stderr, "kernel_launch: unexpected shapes n_in %d out %d (want %zu) ws %zu (want %zu)\n", n_in, out_size, (size_t)O_END, ws_size, (size_t)WS_END); grid = -1; return; }
        int dev = 0, cus = 0, per_cu = 0;
        hipGetDevice(&dev);
        hipDeviceGetAttribute(&cus, hipDeviceAttributeMultiprocessorCount, dev);
        if (hipFuncSetAttribute((const void*)fwd_kernel, hipFuncAttributeMaxDynamicSharedMemorySize, LDS_BYTES) != hipSuccess) { fprintf(stderr, "kernel_launch: hipFuncSetAttribute failed\n"); grid = -1; return; }
        if (hipOccupancyMaxActiveBlocksPerMultiprocessor(&per_cu, (const void*)fwd_kernel, 512, LDS_BYTES) != hipSuccess || per_cu < 1) { fprintf(stderr, "kernel_launch: occupancy query says %d\n", per_cu); per_cu = 1; }
        (void)hipGetLastError();
        grid = cus;
    }
    if (grid < 0) return;
    if (hipMemsetAsync((char*)d_ws + WS_BAR, 0, (size_t)3456 * 4, stream) != hipSuccess) { fprintf(stderr, "kernel_launch: memset of barrier words failed\n"); return; }
    Args a{};
    for (int i = 0; i < 33; ++i) a.in[i] = (const float*)d_in[i];
    a.out = (float*)d_out; a.ws = (unsigned char*)d_ws;
#if N_PER_PHASE_LAUNCH
    for (int ph = 0; ph < NPHASES; ++ph) {
        a.ph_lo = ph; a.ph_hi = ph + 1;
        void* args[] = {&a};
        hipError_t e = hipLaunchCooperativeKernel((const void*)fwd_kernel, dim3(grid), dim3(512), args, LDS_BYTES, stream);
        if (e != hipSuccess) { fprintf(stderr, "launch failed: %s\n", hipGetErrorString(e)); return; }
    }
#else
#ifdef DIAG_HI
    a.ph_lo = 0; a.ph_hi = DIAG_HI;
#else
    a.ph_lo = 0; a.ph_hi = NPHASES;
#endif
    void* args[] = {&a};
    hipError_t e = hipLaunchCooperativeKernel((const void*)fwd_kernel, dim3(grid), dim3(512), args, LDS_BYTES, stream);
    if (e != hipSuccess) fprintf(stderr, "cooperative launch failed: %s (grid %d)\n", hipGetErrorString(e), grid);
#endif
}
```

```cpp
#include <hip/hip_runtime.h>
#include <hip/hip_cooperative_groups.h>
#include <cstdio>
#include <cstdint>
namespace cg = cooperative_groups;

#ifndef N_PER_PHASE_LAUNCH
#define N_PER_PHASE_LAUNCH 0
#endif

#define LAS __attribute__((address_space(3)))
typedef unsigned short bf16_t;
typedef short bf16x8 __attribute__((ext_vector_type(8)));
typedef float f32x4 __attribute__((ext_vector_type(4)));
typedef float f32x2 __attribute__((ext_vector_type(2)));
typedef unsigned u32x4 __attribute__((ext_vector_type(4)));
typedef unsigned u32x2 __attribute__((ext_vector_type(2)));

constexpr int D = 1024, FF = 2816, MP = 16384, MS = 128, MV = 16512, MT = 16640, SEQ = 2048, NB = 8;
constexpr int ABN = 3328;
constexpr float ALPHA = 1.4142135623730951f;
constexpr float LN_EPS = 1e-5f;
constexpr int LDS_STAGE = 131072;
constexpr int LDS_BYTES = LDS_STAGE + 64;
constexpr int NPHASES = 34;

constexpr size_t al256(size_t x) { return (x + 255) & ~(size_t)255; }
constexpr size_t WS_WGU = 0;
constexpr size_t WS_WDN = al256(WS_WGU + (size_t)4 * 5632 * 1024 * 2);
constexpr size_t WS_WQ = al256(WS_WDN + (size_t)4 * 1024 * 2816 * 2);
constexpr size_t WS_WO = al256(WS_WQ + (size_t)2 * 1024 * 1024 * 2);
constexpr size_t WS_WKV = al256(WS_WO + (size_t)2 * 1024 * 1024 * 2);
constexpr size_t WS_WABIN = al256(WS_WKV + (size_t)4096 * 1024 * 2);
constexpr size_t WS_WABOUT = al256(WS_WABIN + (size_t)ABN * 1024 * 2);
constexpr size_t WS_WGMIN = al256(WS_WABOUT + (size_t)1024 * 1024 * 2);
constexpr size_t WS_WGMOUT = al256(WS_WGMIN + (size_t)2048 * 1024 * 2);
constexpr size_t WS_WGMS = al256(WS_WGMOUT + (size_t)1024 * 1024 * 2);
constexpr size_t WS_MEMB = al256(WS_WGMS + (size_t)4 * 128 * 128 * 2);
constexpr size_t WS_KB = al256(WS_MEMB + (size_t)2048 * 1024 * 2);
constexpr size_t WS_VT = al256(WS_KB + (size_t)2 * 8 * 256 * 1024 * 2);
constexpr size_t WS_XRES = al256(WS_VT + (size_t)2 * 8 * 1024 * 256 * 2);
constexpr size_t WS_XB = al256(WS_XRES + (size_t)MT * 1024 * 4);
constexpr size_t WS_T = al256(WS_XB + (size_t)MT * 1024 * 2);
constexpr size_t WS_WIDE = al256(WS_T + (size_t)MT * 1024 * 4);
constexpr size_t WS_OC = al256(WS_WIDE + (size_t)MT * ABN * 2);
constexpr size_t WS_QB0 = al256(WS_OC + (size_t)MT * 1024 * 2);
constexpr size_t WS_PB0 = al256(WS_QB0 + (size_t)MT * 1024 * 2);
constexpr size_t WS_ROWSUM = al256(WS_PB0 + (size_t)MT * 1024 * 2);
constexpr size_t WS_GU = al256(WS_ROWSUM + (size_t)2 * MP * 4 * 4);
constexpr size_t WS_GW = al256(WS_GU + (size_t)1024 * 64 * 128 * 4);
constexpr size_t WS_GQG = al256(WS_GW + (size_t)1024 * 64 * 128 * 2);
constexpr size_t WS_GKTT = al256(WS_GQG + (size_t)1024 * 64 * 128 * 2);
constexpr size_t WS_GQK = al256(WS_GKTT + (size_t)1024 * 128 * 64 * 2);
constexpr size_t WS_GGL = al256(WS_GQK + (size_t)1024 * 64 * 64 * 2);
constexpr size_t WS_ORAW0 = al256(WS_GGL + (size_t)1024 * 32 * 4);
constexpr size_t WS_BAR = al256(WS_ORAW0 + (size_t)MV * 512 * 4);
constexpr size_t WS_PART = al256(WS_BAR + (size_t)3456 * 4);
constexpr size_t WS_END = al256(WS_PART + (size_t)11 * 256 * 1024 * 4);

constexpr size_t WS_PB = WS_T;
constexpr size_t WS_ORAW = WS_T;
constexpr size_t WS_QB = WS_GU;
static_assert((size_t)MV * 512 * 4 <= (size_t)MT * 1024 * 4 && (size_t)MT * 1024 * 2 <= (size_t)1024 * 64 * 128 * 4 + (size_t)1024 * 64 * 128 * 2, "alias slots too small");
constexpr size_t O_Y = 0;
constexpr size_t O_MK = O_Y + (size_t)MV * 1024;
constexpr size_t O_MV = O_MK + (size_t)2 * 8 * 256 * 1024;
constexpr size_t O_DNS_P = O_MV + (size_t)2 * 8 * 256 * 1024;
constexpr size_t O_DNC_P = O_DNS_P + (size_t)8 * 4 * 128 * 128;
constexpr size_t O_CCC_P = O_DNC_P + (size_t)8 * 3 * 1536;
constexpr size_t O_DNS_S = O_CCC_P + (size_t)8 * 30 * 512;
constexpr size_t O_DNC_S = O_DNS_S + (size_t)128 * 4 * 128 * 128;
constexpr size_t O_CCC_S = O_DNC_S + (size_t)128 * 3 * 1536;
constexpr size_t O_GMV_S = O_CCC_S + (size_t)128 * 30 * 512;
constexpr size_t O_END = O_GMV_S + (size_t)128 * 1024;

struct Args {
    const float* in[33];
    float* out;
    unsigned char* ws;
    int ph_lo, ph_hi;
};

typedef const __attribute__((address_space(4))) Args* ArgsP;

typedef __bf16 bf16x2_t __attribute__((ext_vector_type(2)));
__device__ __forceinline__ unsigned cvt_pk_bf16(float lo, float hi) { const f32x2 v = (f32x2){lo, hi}; const bf16x2_t r = __builtin_convertvector(v, bf16x2_t); return __builtin_bit_cast(unsigned, r); }
__device__ __forceinline__ bf16_t f2bf(float f) { return (bf16_t)(cvt_pk_bf16(f, 0.f) & 0xffffu); }
__device__ __forceinline__ float bf2f(bf16_t b) { return __uint_as_float(((unsigned)b) << 16); }
__device__ __forceinline__ float bflo(unsigned w) { return __uint_as_float(w << 16); }
__device__ __forceinline__ float bfhi(unsigned w) { return __uint_as_float(w & 0xffff0000u); }
__device__ __forceinline__ float fexp(float x) { return __builtin_amdgcn_exp2f(x * 1.4426950408889634f); }
__device__ __forceinline__ float siluf(float x) { return x * __builtin_amdgcn_rcpf(1.f + fexp(-x)); }
__device__ __forceinline__ float sigmf(float x) { return __builtin_amdgcn_rcpf(1.f + fexp(-x)); }
__device__ __forceinline__ float geluf(float x) { const float t = 1.5957691216057308f * (x + 0.044715f * x * x * x); return x * __builtin_amdgcn_rcpf(1.f + fexp(-t)); }
__device__ __forceinline__ float wave_sum(float v) {
#pragma unroll
    for (int o = 1; o < 64; o <<= 1) v += __shfl_xor(v, o);
    return v;
}
__device__ __forceinline__ float wave_max(float v) {
#pragma unroll
    for (int o = 1; o < 64; o <<= 1) v = fmaxf(v, __shfl_xor(v, o));
    return v;
}
#define LDS_WAIT() asm volatile("s_waitcnt lgkmcnt(0)" ::: "memory")

constexpr int BM = 256, BK = 64, HALF = 128, HTB = HALF * BK * 2, NXCD = 8, WGM = 8;
__device__ __forceinline__ int lds_byte(int r, int c) { const int st = (r >> 4) * 2 + (c >> 5), rr = r & 15, cc = c & 31, ob = rr * 64 + cc * 2; return st * 1024 + (ob ^ (((ob >> 9) & 1) << 5)); }
__device__ __forceinline__ void stage_rc(int b, int& R, int& C) { const int st = b / 1024, sb = b % 1024, swz = sb ^ (((sb >> 9) & 1) << 5); R = (st >> 1) * 16 + swz / 64; C = (st & 1) * 32 + (swz % 64) / 2; }
__device__ __forceinline__ int perm32(int rho) { const int n = rho >> 4, i = rho & 15; return 8 * (i >> 2) + 4 * n + (i & 3); }

struct GemmP {
    const char* A; const char* B;
    long a_pm, a_pn, b_pb, b_pn, a_ks, b_ks;
    int lda, ldb, nt, nM, nN, pn_mask, pn_shift, nsplit, rev;
};
struct EpiA { float* f0; const float* f1; bf16_t* b0; bf16_t* b1; int ldc; float s0, s1; int flag; };

__device__ __forceinline__ bool unit_next(int i, int nM, int nN, int& pm, int& pn, int rev = 0) {
    const int nwg = nM * nN, G = gridDim.x;
    const long L = (long)i * G + (rev ? G - 1 - (int)blockIdx.x : (int)blockIdx.x); if (L >= nwg) return false;
    int wgid = (int)L; { const int q = nwg / NXCD, r = nwg % NXCD, xcd = wgid % NXCD, off = wgid / NXCD; wgid = (xcd < r ? xcd * (q + 1) : r * (q + 1) + (xcd - r) * q) + off; }
    const int nig = WGM * nN, gid = wgid / nig, fm = gid * WGM, gsz = (nM - fm) < WGM ? (nM - fm) : WGM;
    pm = fm + ((wgid % nig) % gsz); pn = (wgid % nig) / gsz; return true;
}

enum { EPI_SWIGLU = 0, EPI_RES = 1, EPI_BF16 = 2, EPI_KV = 3, EPI_SCORES = 4, EPI_PV = 5, EPI_PART = 6 };

template <int MODE>
__device__ __forceinline__ void epilogue(const f32x4 (&acc)[2][2][4][2], int pm, int pn, int wr, int wc, int fr, int fq, const EpiA& e) {
    const int row0 = pm * BM + wr * 64 + fr;
    if constexpr (MODE == EPI_SWIGLU) {
        const int col0 = pn * 128 + wc * 32 + 8 * fq;
#pragma unroll
        for (int ai = 0; ai < 2; ++ai)
#pragma unroll
            for (int m = 0; m < 4; ++m) {
                const size_t row = (size_t)(row0 + ai * HALF + m * 16);
                float h[8];
#pragma unroll
                for (int n = 0; n < 2; ++n)
#pragma unroll
                    for (int j = 0; j < 4; ++j) h[n * 4 + j] = siluf(acc[ai][0][m][n][j]) * acc[ai][1][m][n][j];
                u32x4 w; w.x = cvt_pk_bf16(h[0], h[1]); w.y = cvt_pk_bf16(h[2], h[3]); w.z = cvt_pk_bf16(h[4], h[5]); w.w = cvt_pk_bf16(h[6], h[7]);
                *(u32x4*)(e.b0 + row * e.ldc + col0) = w;
            }
    } else if constexpr (MODE == EPI_RES) {
        const int col0 = pn * BM + wc * 32 + 4 * fq;
#pragma unroll
        for (int ai = 0; ai < 2; ++ai) {
            u32x2 xr[4][2][2];
#pragma unroll
            for (int m = 0; m < 4; ++m)
#pragma unroll
                for (int bj = 0; bj < 2; ++bj)
#pragma unroll
                    for (int n = 0; n < 2; ++n) xr[m][bj][n] = *(const u32x2*)(e.b1 + (size_t)(row0 + ai * HALF + m * 16) * 1024 + col0 + bj * HALF + n * 16);
#pragma unroll
            for (int m = 0; m < 4; ++m)
#pragma unroll
                for (int bj = 0; bj < 2; ++bj)
#pragma unroll
                    for (int n = 0; n < 2; ++n) {
                        const u32x2 xw = xr[m][bj][n]; const f32x4 x = (f32x4){bflo(xw.x), bfhi(xw.x), bflo(xw.y), bfhi(xw.y)};
                        const f32x4 t = x * e.s0 + acc[ai][bj][m][n] * e.s1;
                        u32x2 w; w.x = cvt_pk_bf16(t[0], t[1]); w.y = cvt_pk_bf16(t[2], t[3]);
                        *(u32x2*)(e.b0 + (size_t)(row0 + ai * HALF + m * 16) * 1024 + col0 + bj * HALF + n * 16) = w;
                    }
            asm volatile("" ::: "memory");
        }
    } else if constexpr (MODE == EPI_BF16) {
        const int col0 = pn * BM + wc * 32 + 8 * fq;
#pragma unroll
        for (int ai = 0; ai < 2; ++ai)
#pragma unroll
            for (int m = 0; m < 4; ++m) {
                bf16_t* rowp = e.b0 + (size_t)(row0 + ai * HALF + m * 16) * e.ldc + col0;
#pragma unroll
                for (int bj = 0; bj < 2; ++bj) {
                    f32x4 v0 = acc[ai][bj][m][0], v1 = acc[ai][bj][m][1];
                    if (e.flag) {
#pragma unroll
                        for (int j = 0; j < 4; ++j) { v0[j] = geluf(v0[j]); v1[j] = geluf(v1[j]); }
                    }
                    u32x4 w; w.x = cvt_pk_bf16(v0[0], v0[1]); w.y = cvt_pk_bf16(v0[2], v0[3]); w.z = cvt_pk_bf16(v1[0], v1[1]); w.w = cvt_pk_bf16(v1[2], v1[3]);
                    *(u32x4*)(rowp + bj * HALF) = w;
                }
            }
    } else if constexpr (MODE == EPI_KV) {
        const int sel = pn >> 2, l = sel >> 1, kv = sel & 1;
        const int e0 = (pn & 3) * BM + wc * 32 + 4 * fq;
        float* ob = e.f0 + (kv ? O_MV : O_MK) + (size_t)(l * 8 + pm) * 256 * 1024;
        bf16_t* kb = e.b0 + (size_t)(l * 8 + pm) * 256 * 1024;
        bf16_t* vt = e.b1 + (size_t)(l * 8 + pm) * 1024 * 256;
#pragma unroll
        for (int ai = 0; ai < 2; ++ai)
#pragma unroll
            for (int m = 0; m < 4; ++m) {
                const int mm = wr * 64 + fr + ai * HALF + m * 16;
#pragma unroll
                for (int bj = 0; bj < 2; ++bj)
#pragma unroll
                    for (int n = 0; n < 2; ++n) {
                        const int ee = e0 + bj * HALF + n * 16;
                        const f32x4 v = acc[ai][bj][m][n];
                        __builtin_nontemporal_store(v, (f32x4*)(ob + (size_t)mm * 1024 + ee));
                        if (kv == 0) { u32x2 w; w.x = cvt_pk_bf16(v[0], v[1]); w.y = cvt_pk_bf16(v[2], v[3]); *(u32x2*)(kb + (size_t)mm * 1024 + ee) = w; }
                        else {
#pragma unroll
                            for (int j = 0; j < 4; ++j) vt[(size_t)(ee + j) * 256 + mm] = f2bf(v[j]);
                        }
                    }
            }
    } else if constexpr (MODE == EPI_SCORES) {
        const int col0 = pn * BM + wc * 32 + 8 * fq;
#pragma unroll
        for (int ai = 0; ai < 2; ++ai)
#pragma unroll
            for (int m = 0; m < 4; ++m) {
                const size_t row = (size_t)(row0 + ai * HALF + m * 16);
                float s = 0.f;
#pragma unroll
                for (int bj = 0; bj < 2; ++bj) {
                    float p[8];
#pragma unroll
                    for (int n = 0; n < 2; ++n)
#pragma unroll
                        for (int j = 0; j < 4; ++j) { p[n * 4 + j] = __builtin_amdgcn_exp2f(acc[ai][bj][m][n][j] * (0.0625f * 1.4426950408889634f)); s += p[n * 4 + j]; }
                    u32x4 w; w.x = cvt_pk_bf16(p[0], p[1]); w.y = cvt_pk_bf16(p[2], p[3]); w.z = cvt_pk_bf16(p[4], p[5]); w.w = cvt_pk_bf16(p[6], p[7]);
                    *(u32x4*)(e.b0 + row * 1024 + col0 + bj * HALF) = w;
                }
                s += __shfl_xor(s, 16); s += __shfl_xor(s, 32);
                if (fq == 0) atomicAdd(e.f0 + row * 4 + pn, s);
            }
    } else if constexpr (MODE == EPI_PART) {
        float* base = e.f0 + (size_t)(pn >> 2) * 256 * 1024 + (size_t)(wr * 64 + fr) * 1024 + (pn & 3) * BM + wc * 32 + 4 * fq;
#pragma unroll
        for (int ai = 0; ai < 2; ++ai)
#pragma unroll
            for (int m = 0; m < 4; ++m)
#pragma unroll
                for (int bj = 0; bj < 2; ++bj)
#pragma unroll
                    for (int n = 0; n < 2; ++n) *(f32x4*)(base + (size_t)(ai * HALF + m * 16) * 1024 + bj * HALF + n * 16) = acc[ai][bj][m][n];
    } else if constexpr (MODE == EPI_PV) {
        const int col0 = pn * BM + wc * 32 + 8 * fq;
        float rs[2][4];
#pragma unroll
        for (int ai = 0; ai < 2; ++ai)
#pragma unroll
            for (int m = 0; m < 4; ++m) rs[ai][m] = e.f1[(size_t)(row0 + ai * HALF + m * 16) * 4 + pn];
#pragma unroll
        for (int ai = 0; ai < 2; ++ai)
#pragma unroll
            for (int m = 0; m < 4; ++m) {
                const size_t row = (size_t)(row0 + ai * HALF + m * 16);
                const float inv = 1.f / rs[ai][m];
#pragma unroll
                for (int bj = 0; bj < 2; ++bj) {
                    const f32x4 v0 = acc[ai][bj][m][0] * inv, v1 = acc[ai][bj][m][1] * inv;
                    u32x4 w; w.x = cvt_pk_bf16(v0[0], v0[1]); w.y = cvt_pk_bf16(v0[2], v0[3]); w.z = cvt_pk_bf16(v1[0], v1[1]); w.w = cvt_pk_bf16(v1[2], v1[3]);
                    *(u32x4*)(e.b0 + row * 1024 + col0 + bj * HALF) = w;
                }
            }
    }
}

template <bool PERMUTED>
__device__ __forceinline__ void epilogue_part(const f32x4 (&acc)[2][2][4][2], int pn, int wr, int wc, int fr, int fq, float* part) {
    float* base = part + (size_t)(pn >> 2) * 256 * 1024 + (size_t)(wr * 64 + fr) * 1024 + (pn & 3) * BM + wc * 32 + (PERMUTED ? 8 * fq : 4 * fq);
#pragma unroll
    for (int ai = 0; ai < 2; ++ai)
#pragma unroll
        for (int m = 0; m < 4; ++m)
#pragma unroll
            for (int bj = 0; bj < 2; ++bj)
#pragma unroll
                for (int n = 0; n < 2; ++n) *(f32x4*)(base + (size_t)(ai * HALF + m * 16) * 1024 + bj * HALF + (PERMUTED ? 4 * n : 16 * n)) = acc[ai][bj][m][n];
}

template <int MODE>
__device__ __forceinline__ void gemm_phase(LAS unsigned char* lds, const GemmP g, const EpiA e) {
    constexpr bool PERM = (MODE == EPI_SWIGLU || MODE == EPI_BF16 || MODE == EPI_SCORES || MODE == EPI_PV);
    int tid_ = threadIdx.x; asm volatile("" : "+v"(tid_));
    const int tid = tid_, wid = __builtin_amdgcn_readfirstlane(tid >> 6), lane = tid & 63, wr = wid >> 2, wc = wid & 3, fr = lane & 15, fq = lane >> 4;
    const int nt = g.nt;
    unsigned voffA[2], voffB[2];
#pragma unroll
    for (int i = 0; i < 2; ++i) { int R, C; stage_rc(tid * 16 + i * 8192, R, C); const int Rb = PERM ? ((R & ~31) + perm32(R & 31)) : R;
        voffA[i] = (unsigned)(R * g.lda + C) * 2u; voffB[i] = (unsigned)(Rb * g.ldb + C) * 2u; }
    const size_t kstep = (size_t)(BK * 2);
    const size_t hstepA = (size_t)HALF * g.lda * 2, hstepB = (size_t)HALF * g.ldb * 2;
    const unsigned ldsw = (unsigned)wid * 1024u;
    const int aoff = lds_byte(wr * 64 + fr, fq * 8), boff = lds_byte(wc * 32 + fr, fq * 8);
#define PG8_SA(b, h) (((b) * 2 + (h)) * HTB)
#define PG8_SB(b, h) ((4 + (b) * 2 + (h)) * HTB)
#define PG8_STAGE(bufoff, gbase, voff) do { _Pragma("unroll") for (int _i = 0; _i < 2; ++_i) \
        __builtin_amdgcn_global_load_lds((const unsigned*)((const char*)(gbase) + (voff)[_i]), (LAS unsigned*)(lds + (bufoff) + ldsw + _i * 8192), 16, 0, 0); } while (0)
#define PG8_LDA(dst, b, h) do { _Pragma("unroll") for (int m = 0; m < 4; ++m) _Pragma("unroll") for (int k = 0; k < 2; ++k) dst[m][k] = *(const LAS bf16x8*)(lds + PG8_SA(b, h) + aoff + m * 2048 + k * 1024); } while (0)
#define PG8_LDB(dst, b, h) do { _Pragma("unroll") for (int n = 0; n < 2; ++n) _Pragma("unroll") for (int k = 0; k < 2; ++k) dst[n][k] = *(const LAS bf16x8*)(lds + PG8_SB(b, h) + boff + n * 2048 + k * 1024); } while (0)
#define PG8_MMA(ai, bj, At, Bt) do { __builtin_amdgcn_s_setprio(1); _Pragma("unroll") for (int m = 0; m < 4; ++m) _Pragma("unroll") for (int n = 0; n < 2; ++n) _Pragma("unroll") for (int k = 0; k < 2; ++k) \
        acc[ai][bj][m][n] = __builtin_amdgcn_mfma_f32_16x16x32_bf16(Bt[n][k], At[m][k], acc[ai][bj][m][n], 0, 0, 0); __builtin_amdgcn_s_setprio(0); } while (0)
#define PG8_WAIT_V(n) asm volatile("s_waitcnt vmcnt(" #n ")" ::: "memory")
#define PG8_WAIT_L(n) asm volatile("s_waitcnt lgkmcnt(" #n ")" ::: "memory")
#define PG8_BAR __builtin_amdgcn_s_barrier()
#define PG8_SCHED __builtin_amdgcn_sched_barrier(0)
    int cpm, cpn, npm = 0, npn = 0, ui = 0; bool csp = false, nsp = false;
    auto get_unit = [&](int i, int& pm, int& pn, bool& sp) -> bool {
        if (unit_next(i, g.nM, g.nN, pm, pn, g.rev)) { sp = false; return true; }
        if (g.nsplit > 0) {
            const int G_ = gridDim.x, bx_ = blockIdx.x, nwg_ = g.nM * g.nN;
            const int nmain = bx_ < nwg_ ? (nwg_ - bx_ + G_ - 1) / G_ : 0;
            const int L = (i - nmain) * G_ + (G_ - 1 - bx_);
            if (i >= nmain && L < 4 * g.nsplit) { pm = 64; pn = L; sp = true; return true; }
        }
        return false;
    };
    auto base_a = [&](int pm, int pn, bool sp) -> const char* {
        return sp ? g.A + (size_t)64 * g.a_pm + (size_t)(pn >> 2) * 512 : g.A + (size_t)pm * g.a_pm + (size_t)(pn & g.pn_mask) * g.a_pn + (size_t)(pn >> g.pn_shift) * g.a_ks; };
    auto base_b = [&](int pm, int pn, bool sp) -> const char* {
        return sp ? g.B + (size_t)(pn & 3) * g.b_pn + (size_t)(pn >> 2) * 512 : g.B + (size_t)(pm >> 3) * g.b_pb + (size_t)(pn & g.pn_mask) * g.b_pn + (size_t)(pn >> g.pn_shift) * g.b_ks; };
    if (!get_unit(0, cpm, cpn, csp)) return;
    f32x4 acc[2][2][4][2];
#pragma unroll
    for (int a = 0; a < 2; ++a)
#pragma unroll
        for (int b = 0; b < 2; ++b)
#pragma unroll
            for (int m = 0; m < 4; ++m)
#pragma unroll
                for (int n = 0; n < 2; ++n) acc[a][b][m][n] = (f32x4){0.f, 0.f, 0.f, 0.f};
    bf16x8 At[4][2], B0[2][2], B1[2][2];
    const char* cA = base_a(cpm, cpn, csp);
    const char* cB = base_b(cpm, cpn, csp);
    PG8_STAGE(PG8_SB(0, 0), cB, voffB); PG8_STAGE(PG8_SA(0, 0), cA, voffA); PG8_STAGE(PG8_SB(0, 1), cB + hstepB, voffB); PG8_STAGE(PG8_SA(0, 1), cA + hstepA, voffA);
    if (wr == 1) PG8_BAR;
    PG8_WAIT_V(4); PG8_BAR;
    PG8_STAGE(PG8_SB(1, 0), cB + kstep, voffB); PG8_STAGE(PG8_SA(1, 0), cA + kstep, voffA); PG8_STAGE(PG8_SB(1, 1), cB + hstepB + kstep, voffB);
    PG8_WAIT_V(6); PG8_BAR;
    for (;;) {
        const bool has_next = get_unit(ui + 1, npm, npn, nsp);
        const char* nA = has_next ? base_a(npm, npn, nsp) : cA;
        const char* nB = has_next ? base_b(npm, npn, nsp) : cB;
        const int cnt = csp ? 4 : nt;
        for (int t = 0; t < cnt; t += 2) {
            const bool last = (t == cnt - 2);
            const char* a1 = cA + (size_t)(t + 1) * kstep;
            const char* a2 = last ? nA : cA + (size_t)(t + 2) * kstep; const char* b2 = last ? nB : cB + (size_t)(t + 2) * kstep;
            const char* a3 = a2 + kstep; const char* b3 = b2 + kstep;
            PG8_LDB(B0, 0, 0); PG8_SCHED; PG8_LDA(At, 0, 0); PG8_STAGE(PG8_SA(1, 1), a1 + hstepA, voffA);
            PG8_WAIT_L(8); PG8_BAR; PG8_WAIT_L(0); PG8_MMA(0, 0, At, B0); PG8_BAR; PG8_SCHED;
            PG8_LDB(B1, 0, 1); PG8_STAGE(PG8_SB(0, 0), b2, voffB);
            PG8_BAR; PG8_WAIT_L(0); PG8_MMA(0, 1, At, B1); PG8_BAR;
            PG8_LDA(At, 0, 1); PG8_STAGE(PG8_SA(0, 0), a2, voffA);
            PG8_BAR; PG8_WAIT_L(0); PG8_MMA(1, 0, At, B0); PG8_BAR; PG8_SCHED;
            PG8_STAGE(PG8_SB(0, 1), b2 + hstepB, voffB);
            PG8_WAIT_V(6); PG8_BAR; PG8_MMA(1, 1, At, B1); PG8_BAR;
            PG8_LDB(B0, 1, 0); PG8_SCHED; PG8_LDA(At, 1, 0); PG8_STAGE(PG8_SA(0, 1), a2 + hstepA, voffA);
            PG8_WAIT_L(8); PG8_BAR; PG8_WAIT_L(0); PG8_MMA(0, 0, At, B0); PG8_BAR; PG8_SCHED;
            PG8_LDB(B1, 1, 1); PG8_STAGE(PG8_SB(1, 0), b3, voffB);
            PG8_BAR; PG8_WAIT_L(0); PG8_MMA(0, 1, At, B1); PG8_BAR;
            PG8_LDA(At, 1, 1); PG8_STAGE(PG8_SA(1, 0), a3, voffA);
            PG8_BAR; PG8_WAIT_L(0); PG8_MMA(1, 0, At, B0); PG8_BAR; PG8_SCHED;
            PG8_STAGE(PG8_SB(1, 1), b3 + hstepB, voffB);
            PG8_WAIT_V(6); PG8_BAR; PG8_MMA(1, 1, At, B1); PG8_BAR;
        }
        if (csp) epilogue_part<PERM>(acc, cpn, wr, wc, fr, fq, e.f0); else epilogue<MODE>(acc, cpm, cpn, wr, wc, fr, fq, e);
        if (!has_next) break;
#pragma unroll
        for (int a = 0; a < 2; ++a)
#pragma unroll
            for (int b = 0; b < 2; ++b)
#pragma unroll
                for (int m = 0; m < 4; ++m)
#pragma unroll
                    for (int n = 0; n < 2; ++n) acc[a][b][m][n] = (f32x4){0.f, 0.f, 0.f, 0.f};
        cpm = npm; cpn = npn; csp = nsp; cA = nA; cB = nB; ++ui;
    }
    PG8_WAIT_V(0);
    if (wr == 0) PG8_BAR;
    PG8_BAR;
#undef PG8_SA
#undef PG8_SB
#undef PG8_STAGE
#undef PG8_LDA
#undef PG8_LDB
#undef PG8_MMA
#undef PG8_WAIT_V
#undef PG8_WAIT_L
#undef PG8_BAR
#undef PG8_SCHED
}

__device__ __forceinline__ GemmP mk_gemm(const void* A, int lda, const void* B, int ldb, int K, int nM, int nN) {
    GemmP g; g.A = (const char*)A; g.B = (const char*)B; g.a_pm = (long)BM * lda * 2; g.a_pn = 0; g.b_pb = 0; g.b_pn = (long)BM * ldb * 2;
    g.lda = lda; g.ldb = ldb; g.nt = K / BK; g.nM = nM; g.nN = nN; g.a_ks = 0; g.b_ks = 0; g.pn_mask = 0x7fffffff; g.pn_shift = 30; g.nsplit = 0; g.rev = 0; return g;
}
__device__ __forceinline__ GemmP mk_gemm_split(const bf16_t* A, int lda, const bf16_t* B, int ldb, int K) {
    GemmP g = mk_gemm(A + (size_t)MP * lda, lda, B, ldb, 256, 1, 4 * (K / 256));
    g.a_pn = 0; g.a_ks = 512; g.b_ks = 512; g.pn_mask = 3; g.pn_shift = 2; return g;
}

__device__ __forceinline__ void tr_load(const float* src, int sld, int nvalid, int lane, f32x4 (&v)[8]) {
    const int n4 = (lane & 7) * 4;
#pragma unroll
    for (int i = 0; i < 8; ++i) { const int kk = 8 * i + (lane >> 3); v[i] = (n4 < nvalid) ? __builtin_nontemporal_load((const f32x4*)(src + (size_t)kk * sld + n4)) : (f32x4){0.f, 0.f, 0.f, 0.f}; }
}
__device__ __forceinline__ void tr_finish(const f32x4 (&v)[8], bf16_t* dst, int dld, LAS float* scr, int lane, bool late) {
    const int n4 = (lane & 7) * 4;
#pragma unroll
    for (int i = 0; i < 8; ++i) { const int kk = 8 * i + (lane >> 3); LAS float* d = scr + kk * 33 + n4; d[0] = v[i][0]; d[1] = v[i][1]; d[2] = v[i][2]; d[3] = v[i][3]; }
    LDS_WAIT(); asm volatile("" ::: "memory");
    const int c = lane & 7;
#pragma unroll
    for (int j = 0; j < 4; ++j) { const int n = (lane >> 3) + 8 * j; const LAS float* s = scr + (8 * c) * 33 + n;
        u32x4 o; o.x = cvt_pk_bf16(s[0 * 33], s[1 * 33]); o.y = cvt_pk_bf16(s[2 * 33], s[3 * 33]); o.z = cvt_pk_bf16(s[4 * 33], s[5 * 33]); o.w = cvt_pk_bf16(s[6 * 33], s[7 * 33]);
        if (late) __builtin_nontemporal_store(o, (u32x4*)(dst + (size_t)n * dld + 8 * c));
        else *(u32x4*)(dst + (size_t)n * dld + 8 * c) = o; }
    LDS_WAIT(); asm volatile("" ::: "memory");
}

__device__ __noinline__ void prep_phase(ArgsP a, LAS unsigned char* lds) {
    const int tid = threadIdx.x, lane = tid & 63, wave = tid >> 6;
    unsigned char* ws = a->ws;
    LAS float* scr = (LAS float*)(lds + wave * 8704);
    const int gw = blockIdx.x * 8 + wave, NGW = gridDim.x * 8;
    bf16_t* Wgu = (bf16_t*)(ws + WS_WGU); bf16_t* Wdn = (bf16_t*)(ws + WS_WDN);
    constexpr int I_FFN = 4 * 4224, I_SQ = 512;
    constexpr int NITEMS = I_FFN + 8 * I_SQ + 1024 + 512 + 16 + 512 + 1024 + 512;
    f32x4 vp[8]; bf16_t* dstp = nullptr; int dldp = 0; bool latep = false, havep = false;
#pragma unroll 1
    for (int it = gw; it < NITEMS; it += NGW) {
        int r = it;
        const float* src; bf16_t* dst; int sld, dld, nvalid = 32; bool late = true;
        bf16_t* Wab = (bf16_t*)(ws + WS_WABIN);
        if (r < I_FFN) {
            const int ls = r / 4224; r %= 4224; const int which = r / 1408; r %= 1408; late = ls != 0;
            if (which < 2) { const int kb = r / 88, nb = r % 88, n0 = nb * 32, k0 = kb * 64;
                src = a->in[which == 0 ? 10 : 11] + (size_t)ls * 1024 * 2816 + (size_t)k0 * 2816 + n0; sld = 2816;
                const int drow = (n0 / 128) * 256 + which * 128 + (n0 % 128);
                dst = Wgu + ((size_t)ls * 5632 + drow) * 1024 + k0; dld = 1024;
            } else { const int kb = r / 32, nb = r % 32, n0 = nb * 32, k0 = kb * 64;
                src = a->in[12] + (size_t)ls * 2816 * 1024 + (size_t)k0 * 1024 + n0; sld = 1024;
                dst = Wdn + ((size_t)ls * 1024 + n0) * 2816 + k0; dld = 2816; }
        } else if ((r -= I_FFN) < 8 * I_SQ) {
            const int mat = r / 1024; r %= 1024; const int l = r / 512; r %= 512;
            const int kb = r / 32, nb = r % 32, n0 = nb * 32, k0 = kb * 64;
            src = a->in[13 + mat] + (size_t)l * 1024 * 1024 + (size_t)k0 * 1024 + n0; sld = 1024; dld = 1024;
            if (mat == 0) dst = (bf16_t*)(ws + WS_WQ) + ((size_t)l * 1024 + n0) * 1024 + k0;
            else if (mat == 3) dst = (bf16_t*)(ws + WS_WO) + ((size_t)l * 1024 + n0) * 1024 + k0;
            else { dst = (bf16_t*)(ws + WS_WKV) + ((size_t)(l * 2 + (mat - 1)) * 1024 + n0) * 1024 + k0; late = false; }
        } else if ((r -= 8 * I_SQ) < 1024) { const int kb = r / 64, nb = r % 64, n0 = nb * 32, k0 = kb * 64;
            src = a->in[17] + (size_t)k0 * 3080 + n0; sld = 3080; dst = Wab + (size_t)n0 * 1024 + k0; dld = 1024; late = false;
        } else if ((r -= 1024) < 512) { const int kb = r / 32, nb = r % 32, n0 = nb * 32, k0 = kb * 64;
            src = a->in[17] + (size_t)k0 * 3080 + 2056 + n0; sld = 3080; dst = Wab + (size_t)(2048 + n0) * 1024 + k0; dld = 1024; late = false;
        } else if ((r -= 512) < 16) { const int k0 = r * 64;
            src = a->in[17] + (size_t)k0 * 3080 + 2048; sld = 3080; dst = Wab + (size_t)3072 * 1024 + k0; dld = 1024; nvalid = 8; late = false;
        } else if ((r -= 16) < 512) { const int kb = r / 32, nb = r % 32, n0 = nb * 32, k0 = kb * 64;
            src = a->in[26] + (size_t)k0 * 1024 + n0; sld = 1024; dst = (bf16_t*)(ws + WS_WABOUT) + (size_t)n0 * 1024 + k0; dld = 1024;
        } else if ((r -= 512) < 1024) { const int kb = r / 64, nb = r % 64, n0 = nb * 32, k0 = kb * 64;
            src = a->in[27] + (size_t)k0 * 2048 + n0; sld = 2048; dst = (bf16_t*)(ws + WS_WGMIN) + (size_t)n0 * 1024 + k0; dld = 1024;
        } else { r -= 1024; const int kb = r / 32, nb = r % 32, n0 = nb * 32, k0 = kb * 64;
            src = a->in[32] + (size_t)k0 * 1024 + n0; sld = 1024; dst = (bf16_t*)(ws + WS_WGMOUT) + (size_t)n0 * 1024 + k0; dld = 1024; }
        f32x4 vn[8]; tr_load(src, sld, nvalid, lane, vn);
        if (havep) tr_finish(vp, dstp, dldp, scr, lane, latep);
#pragma unroll
        for (int i = 0; i < 8; ++i) vp[i] = vn[i];
        dstp = dst; dldp = dld; latep = late; havep = true;
    }
    if (havep) tr_finish(vp, dstp, dldp, scr, lane, latep);
    bf16_t* XB = (bf16_t*)(ws + WS_XB); bf16_t* MEMB = (bf16_t*)(ws + WS_MEMB);
#pragma unroll 1
    for (int row = gw; row < MT + 2048; row += NGW) {
        if (row < MT) {
            const float* src = row < MP ? a->in[0] + (size_t)row * 1024 : a->in[1] + (size_t)(row - MP) * 1024;
#pragma unroll
            for (int j = 0; j < 4; ++j) { f32x4 v = (f32x4){0.f, 0.f, 0.f, 0.f}; if (row < MV) v = __builtin_nontemporal_load((const f32x4*)(src + (lane + 64 * j) * 4));
                u32x2 w; w.x = cvt_pk_bf16(v[0], v[1]); w.y = cvt_pk_bf16(v[2], v[3]); *(u32x2*)(XB + (size_t)row * 1024 + (lane + 64 * j) * 4) = w; }
        } else {
            const int mr = row - MT; const float* src = a->in[2] + (size_t)mr * 1024;
#pragma unroll
            for (int j = 0; j < 4; ++j) { const f32x4 v = __builtin_nontemporal_load((const f32x4*)(src + (lane + 64 * j) * 4));
                u32x2 w; w.x = cvt_pk_bf16(v[0], v[1]); w.y = cvt_pk_bf16(v[2], v[3]); *(u32x2*)(MEMB + (size_t)mr * 1024 + (lane + 64 * j) * 4) = w; }
        }
    }
    const size_t gt = (size_t)blockIdx.x * 512 + tid, NGT = (size_t)gridDim.x * 512;
    { u32x4* z = (u32x4*)((bf16_t*)(ws + WS_WABIN) + (size_t)3104 * 1024); const size_t n = (size_t)(ABN - 3104) * 1024 * 2 / 16;
      for (size_t i = gt; i < n; i += NGT) z[i] = (u32x4){0u, 0u, 0u, 0u}; }
    { u32x4* z = (u32x4*)(ws + WS_ROWSUM); const size_t n = (size_t)2 * MP * 4 * 4 / 16;
      for (size_t i = gt; i < n; i += NGT) z[i] = (u32x4){0u, 0u, 0u, 0u}; }
    { bf16_t* o = (bf16_t*)(ws + WS_WGMS);
      for (size_t i = gt; i < (size_t)4 * 128 * 128; i += NGT) { const int ii = (int)((i >> 7) & 127), jj = (int)(i & 127); o[i] = f2bf(jj <= ii ? a->in[30][i] : 0.f); } }
}

__device__ __forceinline__ void ln_row_finish(f32x4 (&v)[4], const f32x4 (&gv)[4], const f32x4 (&bv)[4], bf16_t* XB, float* yout, size_t row, int lane) {
    float s = 0.f;
#pragma unroll
    for (int j = 0; j < 4; ++j) s += (v[j][0] + v[j][1]) + (v[j][2] + v[j][3]);
    const float mean = wave_sum(s) * (1.f / 1024.f); float q = 0.f;
#pragma unroll
    for (int j = 0; j < 4; ++j) { v[j] = v[j] - mean; q += (v[j][0] * v[j][0] + v[j][1] * v[j][1]) + (v[j][2] * v[j][2] + v[j][3] * v[j][3]); }
    const float rstd = rsqrtf(wave_sum(q) * (1.f / 1024.f) + LN_EPS);
#pragma unroll
    for (int j = 0; j < 4; ++j) { const f32x4 o = v[j] * rstd * gv[j] + bv[j];
        u32x2 w; w.x = cvt_pk_bf16(o[0], o[1]); w.y = cvt_pk_bf16(o[2], o[3]); *(u32x2*)(XB + row * 1024 + (lane + 64 * j) * 4) = w;
        if (yout) __builtin_nontemporal_store(o, (f32x4*)(yout + row * 1024 + (lane + 64 * j) * 4)); }
}
__device__ __forceinline__ f32x4 ld_bf4(const bf16_t* p) { const u32x2 w = *(const u32x2*)p; return (f32x4){bflo(w.x), bfhi(w.x), bflo(w.y), bfhi(w.y)}; }
__device__ __noinline__ void ln_phase(ArgsP a, int l, int idx, bool final_out, int nsplit, float scale) {
    const int lane = threadIdx.x & 63, wave = threadIdx.x >> 6;
    const int gw = blockIdx.x * 8 + wave, NGW = gridDim.x * 8;
    const bf16_t* T = (const bf16_t*)(a->ws + WS_T); bf16_t* XB = (bf16_t*)(a->ws + WS_XB);
    float* yout = final_out ? a->out + O_Y : nullptr;
    const float* g = a->in[8] + (size_t)(l * 4 + idx) * 1024; const float* b = a->in[9] + (size_t)(l * 4 + idx) * 1024;
    f32x4 gv[4], bv[4];
#pragma unroll
    for (int j = 0; j < 4; ++j) { gv[j] = *(const f32x4*)(g + (lane + 64 * j) * 4); bv[j] = *(const f32x4*)(b + (lane + 64 * j) * 4); }
    for (int row = MP + gw; row < MV; row += NGW) {
        f32x4 v[4];
#pragma unroll
        for (int j = 0; j < 4; ++j) {
            f32x4 p = (f32x4){0.f, 0.f, 0.f, 0.f};
            for (int ks = 0; ks < nsplit; ++ks) p += *(const f32x4*)((const float*)(a->ws + WS_PART) + ((size_t)ks * 256 + (row - MP)) * 1024 + (lane + 64 * j) * 4);
            v[j] = ld_bf4(XB + (size_t)row * 1024 + (lane + 64 * j) * 4) * ALPHA + p * scale;
        }
        ln_row_finish(v, gv, bv, XB, yout, (size_t)row, lane);
    }
    for (int row = gw; row < MP; row += 2 * NGW) {
        const int row2 = row + NGW; const bool has2 = row2 < MP;
        f32x4 v0[4], v1[4];
#pragma unroll
        for (int j = 0; j < 4; ++j) v0[j] = ld_bf4(T + (size_t)row * 1024 + (lane + 64 * j) * 4);
#pragma unroll
        for (int j = 0; j < 4; ++j) v1[j] = has2 ? ld_bf4(T + (size_t)row2 * 1024 + (lane + 64 * j) * 4) : (f32x4){0.f, 0.f, 0.f, 0.f};
        ln_row_finish(v0, gv, bv, XB, yout, (size_t)row, lane);
        if (has2) ln_row_finish(v1, gv, bv, XB, yout, (size_t)row2, lane);
    }
}

constexpr int GST = 132;
__device__ __noinline__ void gdn_prep_item(ArgsP a, LAS unsigned char* lds, int item) {
    const int tid = threadIdx.x, lane = tid & 63, wave = tid >> 6;
    const int bh = item >> 5, n = item & 31, b = bh >> 2, h = bh & 3;
    const bf16_t* PROJ = (const bf16_t*)(a->ws + WS_WIDE);
    LAS float* qs = (LAS float*)lds; LAS float* ks = qs + 64 * GST; LAS float* vs = ks + 64 * GST; LAS float* Ms = vs + 64 * GST;
    LAS float* gc = Ms + 64 * 64; LAS float* bs = gc + 64; LAS float* eg = bs + 64;
    const size_t rowbase = (size_t)b * SEQ + (size_t)n * 64;
    {
        const int c = tid & 127, tq = tid >> 7;
#pragma unroll
        for (int seg = 0; seg < 3; ++seg) {
            const int col = seg * 512 + h * 128 + c;
            const float w0 = a->in[18][col], w1 = a->in[18][1536 + col], w2 = a->in[18][2 * 1536 + col], w3 = a->in[18][3 * 1536 + col];
            LAS float* dst = seg == 0 ? qs : (seg == 1 ? ks : vs);
            const int t0 = tq * 16;
            float x0 = 0.f, x1 = 0.f, x2 = 0.f;
            {
                const long tt = (long)n * 64 + t0;
                if (tt - 3 >= 0) x0 = bf2f(PROJ[(rowbase + t0 - 3) * ABN + col]);
                if (tt - 2 >= 0) x1 = bf2f(PROJ[(rowbase + t0 - 2) * ABN + col]);
                if (tt - 1 >= 0) x2 = bf2f(PROJ[(rowbase + t0 - 1) * ABN + col]);
            }
            bf16_t xr[16];
#pragma unroll
            for (int t = 0; t < 16; ++t) xr[t] = PROJ[(rowbase + t0 + t) * ABN + col];
#pragma unroll
            for (int t = 0; t < 16; ++t) {
                const float x3 = bf2f(xr[t]);
                const float y = w0 * x0 + w1 * x1 + w2 * x2 + w3 * x3;
                dst[(t0 + t) * GST + c] = siluf(y);
                x0 = x1; x1 = x2; x2 = x3;
            }
        }
        if (tid < 64) {
            const float braw = bf2f(PROJ[(rowbase + tid) * ABN + 3072 + h]);
            const float araw = bf2f(PROJ[(rowbase + tid) * ABN + 3076 + h]);
            const float xx = araw + a->in[20][h];
            const float sp = xx > 20.f ? xx : log1pf(__expf(xx));
            float gval = -__expf(a->in[19][h]) * sp;
            bs[tid] = sigmf(braw);
#pragma unroll
            for (int o = 1; o < 64; o <<= 1) { const float nb_ = __shfl_up(gval, o); if (lane >= o) gval += nb_; }
            gc[tid] = gval; eg[tid] = __expf(gval);
        }
    }
    __syncthreads();
    {
        LAS float* base = (wave < 4 ? qs : ks) + ((wave & 3) * 16) * GST;
        float x0[16], x1[16], ss[16];
#pragma unroll
        for (int r = 0; r < 16; ++r) { x0[r] = base[r * GST + lane]; x1[r] = base[r * GST + lane + 64]; ss[r] = x0[r] * x0[r] + x1[r] * x1[r]; }
#pragma unroll
        for (int o = 1; o < 64; o <<= 1)
#pragma unroll
            for (int r = 0; r < 16; ++r) ss[r] += __shfl_xor(ss[r], o);
        const float qsc = wave < 4 ? 0.08838834764831845f : 1.f;
#pragma unroll
        for (int r = 0; r < 16; ++r) { const float sc = rsqrtf(ss[r] + 1e-6f) * qsc; base[r * GST + lane] = x0[r] * sc; base[r * GST + lane + 64] = x1[r] * sc; }
    }
    __syncthreads();
    {
        const int i = tid >> 3, jg = tid & 7;
        float aM[8], aQ[8];
#pragma unroll
        for (int jj = 0; jj < 8; ++jj) { aM[jj] = 0.f; aQ[jj] = 0.f; }
        for (int d = 0; d < 128; d += 4) {
            const f32x4 ki = *(const LAS f32x4*)(ks + i * GST + d), qi = *(const LAS f32x4*)(qs + i * GST + d);
#pragma unroll
            for (int jj = 0; jj < 8; ++jj) {
                const f32x4 kj = *(const LAS f32x4*)(ks + (jg + 8 * jj) * GST + d);
                aM[jj] += (ki[0] * kj[0] + ki[1] * kj[1]) + (ki[2] * kj[2] + ki[3] * kj[3]);
                aQ[jj] += (qi[0] * kj[0] + qi[1] * kj[1]) + (qi[2] * kj[2] + qi[3] * kj[3]);
            }
        }
        const float gi = gc[i], bi = bs[i];
        bf16_t* QK = (bf16_t*)(a->ws + WS_GQK) + (size_t)item * 64 * 64;
#pragma unroll
        for (int jj = 0; jj < 8; ++jj) {
            const int j = jg + 8 * jj;
            const float dec = (j <= i) ? __expf(gi - gc[j]) : 0.f;
            Ms[i * 64 + j] = (j < i) ? bi * aM[jj] * dec : 0.f;
            QK[i * 64 + j] = f2bf(aQ[jj] * dec);
        }
    }
    __syncthreads();
    if (tid < 256) {
        const int c = tid & 127; const bool isw = tid >= 128;
        const LAS float* src = isw ? ks : vs;
        int vz; asm volatile("v_mov_b32 %0, 0" : "=v"(vz));
        const LAS float* Msv = Ms + vz;
        float x[64];
#pragma unroll
        for (int i = 0; i < 64; ++i) x[i] = 0.f;
        float* U = (float*)(a->ws + WS_GU) + (size_t)item * 64 * 128;
        bf16_t* W = (bf16_t*)(a->ws + WS_GW) + (size_t)item * 64 * 128;
#pragma unroll
        for (int i = 0; i < 64; ++i) {
            float acc = src[i * GST + c] * bs[i] * (isw ? eg[i] : 1.f);
#pragma unroll
            for (int j4 = 0; j4 < (i + 3) / 4; ++j4) {
                const f32x4 m = *(const LAS f32x4*)(Msv + i * 64 + j4 * 4);
                acc -= m[0] * x[j4 * 4 + 0]; acc -= m[1] * x[j4 * 4 + 1]; acc -= m[2] * x[j4 * 4 + 2]; acc -= m[3] * x[j4 * 4 + 3];
            }
            x[i] = acc;
            if (isw) W[i * 128 + c] = f2bf(acc); else U[i * 128 + c] = acc;
        }
    } else {
        const int t2 = tid - 256;
        bf16_t* QG = (bf16_t*)(a->ws + WS_GQG) + (size_t)item * 64 * 128;
        bf16_t* KTT = (bf16_t*)(a->ws + WS_GKTT) + (size_t)item * 128 * 64;
        const float glast = gc[63];
        for (int idx = t2; idx < 64 * 128; idx += 256) { const int i = idx >> 7, d = idx & 127; QG[idx] = f2bf(qs[i * GST + d] * eg[i]); }
        for (int idx = t2; idx < 128 * 64; idx += 256) { const int d = idx >> 6, i = idx & 63; KTT[idx] = f2bf(ks[i * GST + d] * __expf(glast - gc[i])); }
        if (t2 == 0) ((float*)(a->ws + WS_GGL))[(size_t)item * 32] = eg[63];
    }
    __syncthreads();
}

__device__ __noinline__ void gdn_sample_item(ArgsP a, LAS unsigned char* lds, int item) {
    const int tid = threadIdx.x, lane = tid & 63, wave = tid >> 6;
    const int b = item >> 2, h = item & 3;
    const bf16_t* PROJ = (const bf16_t*)(a->ws + WS_WIDE) + (size_t)(MP + b) * ABN;
    LAS float* qkv = (LAS float*)lds;
    LAS float* part = qkv + 384;
    LAS float* sc = part + 1024;
    if (tid < 384) {
        const int seg = tid >> 7, c = tid & 127, col = seg * 512 + h * 128 + c;
        const float* buf = a->in[6] + (size_t)b * 3 * 1536;
        const float xn = bf2f(PROJ[col]);
        const float b0 = buf[col], b1 = buf[1536 + col], b2 = buf[2 * 1536 + col];
        const float y = a->in[18][col] * b0 + a->in[18][1536 + col] * b1 + a->in[18][2 * 1536 + col] * b2 + a->in[18][3 * 1536 + col] * xn;
        qkv[tid] = siluf(y);
        float* o = a->out + O_DNC_S + (size_t)b * 3 * 1536;
        o[col] = b1; o[1536 + col] = b2; o[2 * 1536 + col] = xn;
    }
    if (tid == 384) {
        const float braw = bf2f(PROJ[3072 + h]), araw = bf2f(PROJ[3076 + h]);
        const float xx = araw + a->in[20][h]; const float sp = xx > 20.f ? xx : log1pf(__expf(xx));
        sc[1] = sigmf(braw); sc[2] = __expf(-__expf(a->in[19][h]) * sp);
    }
    __syncthreads();
    if (wave < 2) {
        LAS float* p = qkv + wave * 128; const float x0 = p[lane], x1 = p[lane + 64];
        const float ss = wave_sum(x0 * x0 + x1 * x1);
        const float s_ = rsqrtf(ss + 1e-6f) * (wave == 0 ? 0.08838834764831845f : 1.f);
        p[lane] = x0 * s_; p[lane + 64] = x1 * s_;
    }
    __syncthreads();
    if (wave == 0) { const float d = wave_sum(qkv[lane] * qkv[128 + lane] + qkv[lane + 64] * qkv[128 + lane + 64]); if (lane == 0) sc[0] = d; }
    const int e = tid & 127, dq = tid >> 7;
    const float* S0 = a->in[5] + ((size_t)item * 128 + dq * 32) * 128 + e;
    float S[32]; float pk = 0.f, pq = 0.f;
#pragma unroll
    for (int i = 0; i < 32; ++i) { S[i] = __builtin_nontemporal_load(S0 + (size_t)i * 128); }
#pragma unroll
    for (int i = 0; i < 32; ++i) { pk += qkv[128 + dq * 32 + i] * S[i]; pq += qkv[dq * 32 + i] * S[i]; }
    part[dq * 128 + e] = pk; part[512 + dq * 128 + e] = pq;
    __syncthreads();
    const float kS = (part[e] + part[128 + e]) + (part[256 + e] + part[384 + e]);
    const float qS = (part[512 + e] + part[640 + e]) + (part[768 + e] + part[896 + e]);
    const float beta = sc[1], egv = sc[2], qk = sc[0];
    const float vnew = beta * (qkv[256 + e] - egv * kS);
    float* So = a->out + O_DNS_S + ((size_t)item * 128 + dq * 32) * 128 + e;
#pragma unroll
    for (int i = 0; i < 32; ++i) __builtin_nontemporal_store(egv * S[i] + qkv[128 + dq * 32 + i] * vnew, So + (size_t)i * 128);
    if (dq == 0) ((float*)(a->ws + WS_ORAW))[(size_t)(MP + b) * 512 + h * 128 + e] = egv * qS + qk * vnew;
    __syncthreads();
}

__device__ __noinline__ void gdn_scan_item(ArgsP a, LAS unsigned char* lds, int item) {
    const int tid = threadIdx.x, lane = tid & 63, wave = __builtin_amdgcn_readfirstlane(tid >> 6);
    const int bh = item >> 3, sl = item & 7, b = bh >> 2, h = bh & 3, e0 = sl * 16;
    const int ln = lane & 15, kg = lane >> 4;
    LAS bf16_t* ST = (LAS bf16_t*)lds;
    LAS bf16_t* VN = (LAS bf16_t*)(lds + 16 * 136 * 2);
    const float* U = (const float*)(a->ws + WS_GU); const bf16_t* W = (const bf16_t*)(a->ws + WS_GW); const bf16_t* QG = (const bf16_t*)(a->ws + WS_GQG);
    const bf16_t* KTT = (const bf16_t*)(a->ws + WS_GKTT); const bf16_t* QK = (const bf16_t*)(a->ws + WS_GQK); const float* GL = (const float*)(a->ws + WS_GGL);
    float* ORAW = (float*)(a->ws + WS_ORAW);
    f32x4 S = (f32x4){0.f, 0.f, 0.f, 0.f};
    { u32x2 z; z.x = 0u; z.y = 0u; *(LAS u32x2*)(ST + ln * 136 + wave * 16 + kg * 4) = z; }
    __syncthreads();
#ifndef NCH
#define NCH 32
#endif
    for (int n = 0; n < NCH; ++n) {
        const size_t ci = (size_t)bh * 32 + n;
        bf16x8 aw[4], aq[4], aqk[2], akt[2]; f32x4 u = (f32x4){0.f, 0.f, 0.f, 0.f};
#pragma unroll
        for (int k2 = 0; k2 < 2; ++k2) akt[k2] = *(const bf16x8*)(KTT + ci * 8192 + (size_t)(wave * 16 + ln) * 64 + k2 * 32 + kg * 8);
        const float gl = GL[ci * 32];
        f32x4 qsacc = (f32x4){0.f, 0.f, 0.f, 0.f};
        if (wave < 4) {
#pragma unroll
            for (int k4 = 0; k4 < 4; ++k4) { aw[k4] = *(const bf16x8*)(W + ci * 8192 + (size_t)(wave * 16 + ln) * 128 + k4 * 32 + kg * 8);
                                             aq[k4] = *(const bf16x8*)(QG + ci * 8192 + (size_t)(wave * 16 + ln) * 128 + k4 * 32 + kg * 8); }
#pragma unroll
            for (int k2 = 0; k2 < 2; ++k2) aqk[k2] = *(const bf16x8*)(QK + ci * 4096 + (size_t)(wave * 16 + ln) * 64 + k2 * 32 + kg * 8);
#pragma unroll
            for (int j = 0; j < 4; ++j) u[j] = U[ci * 8192 + (size_t)(wave * 16 + kg * 4 + j) * 128 + e0 + ln];
            f32x4 wsacc = (f32x4){0.f, 0.f, 0.f, 0.f};
#pragma unroll
            for (int k4 = 0; k4 < 4; ++k4) {
                const bf16x8 bs_ = *(const LAS bf16x8*)(ST + ln * 136 + k4 * 32 + kg * 8);
                wsacc = __builtin_amdgcn_mfma_f32_16x16x32_bf16(aw[k4], bs_, wsacc, 0, 0, 0);
                qsacc = __builtin_amdgcn_mfma_f32_16x16x32_bf16(aq[k4], bs_, qsacc, 0, 0, 0);
            }
            const f32x4 vn = u - wsacc;
            u32x2 w2; w2.x = cvt_pk_bf16(vn[0], vn[1]); w2.y = cvt_pk_bf16(vn[2], vn[3]);
            *(LAS u32x2*)(VN + ln * 72 + wave * 16 + kg * 4) = w2;
        }
        __syncthreads();
        bf16x8 bv[2];
#pragma unroll
        for (int k2 = 0; k2 < 2; ++k2) bv[k2] = *(const LAS bf16x8*)(VN + ln * 72 + k2 * 32 + kg * 8);
        if (wave < 4) {
#pragma unroll
            for (int k2 = 0; k2 < 2; ++k2) qsacc = __builtin_amdgcn_mfma_f32_16x16x32_bf16(aqk[k2], bv[k2], qsacc, 0, 0, 0);
            const size_t tok = (size_t)b * SEQ + (size_t)n * 64 + wave * 16 + kg * 4;
#pragma unroll
            for (int j = 0; j < 4; ++j) ORAW[(tok + j) * 512 + h * 128 + e0 + ln] = qsacc[j];
        }
        S = S * gl;
#pragma unroll
        for (int k2 = 0; k2 < 2; ++k2) S = __builtin_amdgcn_mfma_f32_16x16x32_bf16(akt[k2], bv[k2], S, 0, 0, 0);
        { u32x2 w2; w2.x = cvt_pk_bf16(S[0], S[1]); w2.y = cvt_pk_bf16(S[2], S[3]); *(LAS u32x2*)(ST + ln * 136 + wave * 16 + kg * 4) = w2; }
        __syncthreads();
    }
    float* So = a->out + O_DNS_P + (size_t)bh * 128 * 128;
#pragma unroll
    for (int j = 0; j < 4; ++j) So[(size_t)(wave * 16 + kg * 4 + j) * 128 + e0 + ln] = S[j];
    __syncthreads();
}

__device__ __noinline__ void gdn_finish_phase(ArgsP a) {
    const int lane = threadIdx.x & 63, wave = threadIdx.x >> 6, sub = lane >> 4, l16 = lane & 15;
    const int gw = blockIdx.x * 8 + wave, NGW = gridDim.x * 8;
    const bf16_t* PROJ = (const bf16_t*)(a->ws + WS_WIDE); const float* ORAW = (const float*)(a->ws + WS_ORAW); bf16_t* OC = (bf16_t*)(a->ws + WS_OC);
    const f32x4 g0 = *(const f32x4*)(a->in[21] + l16 * 8), g1 = *(const f32x4*)(a->in[21] + l16 * 8 + 4);
    for (int p0 = gw * 4; p0 < MV * 4; p0 += NGW * 4) {
        const int p = p0 + sub; const size_t row = (size_t)(p >> 2); const int h = p & 3;
        const f32x4 o0 = *(const f32x4*)(ORAW + row * 512 + h * 128 + l16 * 8), o1 = *(const f32x4*)(ORAW + row * 512 + h * 128 + l16 * 8 + 4);
        const u32x4 zw = *(const u32x4*)(PROJ + row * ABN + 1536 + h * 128 + l16 * 8);
        float ss = (o0[0] * o0[0] + o0[1] * o0[1]) + (o0[2] * o0[2] + o0[3] * o0[3]) + (o1[0] * o1[0] + o1[1] * o1[1]) + (o1[2] * o1[2] + o1[3] * o1[3]);
        ss += __shfl_xor(ss, 1); ss += __shfl_xor(ss, 2); ss += __shfl_xor(ss, 4); ss += __shfl_xor(ss, 8);
        const float r = rsqrtf(ss * (1.f / 128.f) + 1e-6f);
        u32x4 w;
        w.x = cvt_pk_bf16(o0[0] * r * g0[0] * siluf(bflo(zw.x)), o0[1] * r * g0[1] * siluf(bfhi(zw.x)));
        w.y = cvt_pk_bf16(o0[2] * r * g0[2] * siluf(bflo(zw.y)), o0[3] * r * g0[3] * siluf(bfhi(zw.y)));
        w.z = cvt_pk_bf16(o1[0] * r * g1[0] * siluf(bflo(zw.z)), o1[1] * r * g1[1] * siluf(bfhi(zw.z)));
        w.w = cvt_pk_bf16(o1[2] * r * g1[2] * siluf(bflo(zw.w)), o1[3] * r * g1[3] * siluf(bfhi(zw.w)));
        *(u32x4*)(OC + row * 1024 + h * 128 + l16 * 8) = w;
    }
}

__device__ __noinline__ void conf_item(ArgsP a, LAS unsigned char* lds, int item) {
    const int tid = threadIdx.x, lane = tid & 63, wave = tid >> 6;
    const int b = item >> 6, tt = item & 63, t0 = tt * 32;
    const bf16_t* PROJ = (const bf16_t*)(a->ws + WS_WIDE); bf16_t* OC = (bf16_t*)(a->ws + WS_OC);
    LAS float* G = (LAS float*)lds;
    const int ch = tid;
    for (int r0 = 0; r0 < 64; r0 += 8) {
        bf16_t ga[8], gb[8];
#pragma unroll
        for (int k = 0; k < 8; ++k) { const int r = r0 + k, t = t0 - 30 + r; ga[k] = 0; gb[k] = 0;
            if (r < 62 && t >= 0) { const size_t row = (size_t)b * SEQ + t; ga[k] = PROJ[row * ABN + 2048 + ch]; gb[k] = PROJ[row * ABN + 2560 + ch]; } }
#pragma unroll
        for (int k = 0; k < 8; ++k) { const int r = r0 + k;
            if (r < 62) { const float v = bf2f(ga[k]) * sigmf(bf2f(gb[k]));
                G[r * 512 + ch] = v;
                if (tt == 63 && r >= 32) a->out[O_CCC_P + ((size_t)b * 30 + (r - 32)) * 512 + ch] = v; } }
    }
    if (tt == 63) {
        for (int idx = tid; idx < 3 * 1536; idx += 512) { const int rr = idx / 1536, col = idx % 1536;
            a->out[O_DNC_P + (size_t)b * 3 * 1536 + idx] = bf2f(PROJ[((size_t)b * SEQ + 2045 + rr) * ABN + col]); }
    }
    float w[31];
#pragma unroll
    for (int i = 0; i < 31; ++i) w[i] = a->in[22][i * 512 + ch];
    const float bias = a->in[23][ch];
    __syncthreads();
    float co[32];
#pragma unroll
    for (int t = 0; t < 32; ++t) {
        float acc = bias;
#pragma unroll
        for (int i = 0; i < 31; ++i) acc += w[i] * G[(t + i) * 512 + ch];
        co[t] = acc;
    }
    __syncthreads();
#pragma unroll
    for (int t = 0; t < 32; ++t) G[t * 512 + ch] = co[t];
    __syncthreads();
    for (int t = wave * 4; t < wave * 4 + 4; ++t) {
        float v[8]; float s = 0.f;
#pragma unroll
        for (int k = 0; k < 8; ++k) { v[k] = G[t * 512 + lane + 64 * k]; s += v[k]; }
        const float mean = wave_sum(s) * (1.f / 512.f); float q = 0.f;
#pragma unroll
        for (int k = 0; k < 8; ++k) { v[k] -= mean; q += v[k] * v[k]; }
        const float rstd = rsqrtf(wave_sum(q) * (1.f / 512.f) + LN_EPS);
        const size_t row = (size_t)b * SEQ + t0 + t;
#pragma unroll
        for (int k = 0; k < 8; ++k) { const int c = lane + 64 * k; OC[row * 1024 + 512 + c] = f2bf(siluf(v[k] * rstd * a->in[24][c] + a->in[25][c])); }
    }
    __syncthreads();
}

__device__ __noinline__ void conf_sample_item(ArgsP a, LAS unsigned char* lds, int b) {
    const int tid = threadIdx.x, lane = tid & 63, wave = tid >> 6;
    const bf16_t* PROJ = (const bf16_t*)(a->ws + WS_WIDE) + (size_t)(MP + b) * ABN; bf16_t* OC = (bf16_t*)(a->ws + WS_OC);
    LAS float* red = (LAS float*)lds;
    const int ch = tid;
    const float* buf = a->in[7] + (size_t)b * 30 * 512;
    float* ob = a->out + O_CCC_S + (size_t)b * 30 * 512;
    const float gnew = bf2f(PROJ[2048 + ch]) * sigmf(bf2f(PROJ[2560 + ch]));
    float acc = a->in[23][ch] + a->in[22][30 * 512 + ch] * gnew;
    for (int i = 0; i < 30; ++i) { const float v = buf[i * 512 + ch]; acc += a->in[22][i * 512 + ch] * v; if (i >= 1) ob[(i - 1) * 512 + ch] = v; }
    ob[29 * 512 + ch] = gnew;
    float s = wave_sum(acc); if (lane == 0) red[wave] = s;
    __syncthreads();
    float tot = 0.f;
#pragma unroll
    for (int k = 0; k < 8; ++k) tot += red[k];
    const float mean = tot * (1.f / 512.f); const float dv = acc - mean;
    float q = wave_sum(dv * dv); if (lane == 0) red[8 + wave] = q;
    __syncthreads();
    float tq = 0.f;
#pragma unroll
    for (int k = 0; k < 8; ++k) tq += red[8 + k];
    const float rstd = rsqrtf(tq * (1.f / 512.f) + LN_EPS);
    OC[(size_t)(MP + b) * 1024 + 512 + ch] = f2bf(siluf(dv * rstd * a->in[24][ch] + a->in[25][ch]));
    __syncthreads();
}

__device__ __noinline__ void gm_ln_phase(ArgsP a) {
    const int lane = threadIdx.x & 63, wave = threadIdx.x >> 6;
    const int gw = blockIdx.x * 8 + wave, NGW = gridDim.x * 8;
    const bf16_t* PR = (const bf16_t*)(a->ws + WS_WIDE); bf16_t* VLN = (bf16_t*)(a->ws + WS_QB); bf16_t* OC = (bf16_t*)(a->ws + WS_OC);
    for (int row = gw; row < MV; row += NGW) {
        float v[16]; float s = 0.f;
#pragma unroll
        for (int j = 0; j < 2; ++j) { const u32x4 w = *(const u32x4*)(PR + (size_t)row * 2048 + 1024 + (lane + 64 * j) * 8);
            v[j * 8 + 0] = bflo(w.x); v[j * 8 + 1] = bfhi(w.x); v[j * 8 + 2] = bflo(w.y); v[j * 8 + 3] = bfhi(w.y);
            v[j * 8 + 4] = bflo(w.z); v[j * 8 + 5] = bfhi(w.z); v[j * 8 + 6] = bflo(w.w); v[j * 8 + 7] = bfhi(w.w); }
#pragma unroll
        for (int k = 0; k < 16; ++k) s += v[k];
        const float mean = wave_sum(s) * (1.f / 1024.f); float q = 0.f;
#pragma unroll
        for (int k = 0; k < 16; ++k) { v[k] -= mean; q += v[k] * v[k]; }
        const float rstd = rsqrtf(wave_sum(q) * (1.f / 1024.f) + LN_EPS);
#pragma unroll
        for (int j = 0; j < 2; ++j) {
            const int c0 = (lane + 64 * j) * 8; float o[8];
#pragma unroll
            for (int k = 0; k < 8; ++k) o[k] = v[j * 8 + k] * rstd * a->in[28][c0 + k] + a->in[29][c0 + k];
            u32x4 w; w.x = cvt_pk_bf16(o[0], o[1]); w.y = cvt_pk_bf16(o[2], o[3]); w.z = cvt_pk_bf16(o[4], o[5]); w.w = cvt_pk_bf16(o[6], o[7]);
            *(u32x4*)(VLN + (size_t)row * 1024 + c0) = w;
            if (row >= MP) {
                const int gi = c0 >> 8;
                const float ws0 = a->in[30][(size_t)gi * 128 * 128], bs0 = a->in[31][gi * 128];
                const u32x4 uw = *(const u32x4*)(PR + (size_t)row * 2048 + c0);
                float uu[8] = {bflo(uw.x), bfhi(uw.x), bflo(uw.y), bfhi(uw.y), bflo(uw.z), bfhi(uw.z), bflo(uw.w), bfhi(uw.w)};
                float f[8];
#pragma unroll
                for (int k = 0; k < 8; ++k) { a->out[O_GMV_S + (size_t)(row - MP) * 1024 + c0 + k] = o[k]; f[k] = uu[k] * (ws0 * o[k] + bs0); }
                u32x4 w2; w2.x = cvt_pk_bf16(f[0], f[1]); w2.y = cvt_pk_bf16(f[2], f[3]); w2.z = cvt_pk_bf16(f[4], f[5]); w2.w = cvt_pk_bf16(f[6], f[7]);
                *(u32x4*)(OC + (size_t)row * 1024 + c0) = w2;
            }
        }
    }
}

__device__ __noinline__ void gm_mix_item(ArgsP a, LAS unsigned char* lds, int item) {
    const int tid = threadIdx.x, lane = tid & 63, wave = __builtin_amdgcn_readfirstlane(tid >> 6);
    const int ck = item >> 4, sl = item & 15, gi = sl >> 2, c0 = sl * 64;
    const int ln = lane & 15, kg = lane >> 4;
    const bf16_t* VLN = (const bf16_t*)(a->ws + WS_QB); const bf16_t* PR = (const bf16_t*)(a->ws + WS_WIDE); bf16_t* OC = (bf16_t*)(a->ws + WS_OC);
    const bf16_t* WS_ = (const bf16_t*)(a->ws + WS_WGMS) + (size_t)gi * 128 * 128;
    LAS bf16_t* VTl = (LAS bf16_t*)lds;
    const size_t row0 = (size_t)ck * 128;
#pragma unroll
    for (int i = 0; i < 2; ++i) {
        const int q = tid + 512 * i, j = q >> 3, c8 = q & 7;
        const u32x4 w = *(const u32x4*)(VLN + (row0 + j) * 1024 + c0 + c8 * 8);
        LAS bf16_t* d = VTl + (c8 * 8) * 136 + j;
        d[0 * 136] = (bf16_t)(w.x & 0xffff); d[1 * 136] = (bf16_t)(w.x >> 16); d[2 * 136] = (bf16_t)(w.y & 0xffff); d[3 * 136] = (bf16_t)(w.y >> 16);
        d[4 * 136] = (bf16_t)(w.z & 0xffff); d[5 * 136] = (bf16_t)(w.z >> 16); d[6 * 136] = (bf16_t)(w.w & 0xffff); d[7 * 136] = (bf16_t)(w.w >> 16);
    }
    __syncthreads();
    f32x4 acc[4];
#pragma unroll
    for (int cb = 0; cb < 4; ++cb) acc[cb] = (f32x4){0.f, 0.f, 0.f, 0.f};
    const int ksmax = (wave * 16 + 15) >> 5;
    for (int k4 = 0; k4 <= ksmax; ++k4) {
        const bf16x8 af = *(const bf16x8*)(WS_ + (size_t)(wave * 16 + ln) * 128 + k4 * 32 + kg * 8);
#pragma unroll
        for (int cb = 0; cb < 4; ++cb) {
            const bf16x8 bf_ = *(const LAS bf16x8*)(VTl + (cb * 16 + ln) * 136 + k4 * 32 + kg * 8);
            acc[cb] = __builtin_amdgcn_mfma_f32_16x16x32_bf16(af, bf_, acc[cb], 0, 0, 0);
        }
    }
#pragma unroll
    for (int j = 0; j < 4; ++j) {
        const int i = wave * 16 + kg * 4 + j; const float bsv = a->in[31][gi * 128 + i];
#pragma unroll
        for (int cb = 0; cb < 4; ++cb) {
            const int c = c0 + cb * 16 + ln;
            const float u = bf2f(PR[(row0 + i) * 2048 + c]);
            OC[(row0 + i) * 1024 + c] = f2bf(u * (acc[cb][j] + bsv));
        }
    }
    __syncthreads();
}

__device__ __noinline__ void xattn_sample_item(ArgsP a, LAS unsigned char* lds, int l, int item) {
    const int tid = threadIdx.x, lane = tid & 63, wave = tid >> 6;
    const int b = item >> 2, h = item & 3;
    bf16_t* OC = (bf16_t*)(a->ws + WS_OC);
    const float* Kc = a->in[3] + ((size_t)(l * 128 + b) * 256) * 1024 + h * 256;
    const float* Vc = a->in[4] + ((size_t)(l * 128 + b) * 256) * 1024 + h * 256;
    LAS float* sc = (LAS float*)lds;
    LAS float* red = sc + 256;
    LAS float* op = red + 16;
    f32x4 q = (f32x4){0.f, 0.f, 0.f, 0.f};
#pragma unroll
    for (int ks = 0; ks < 4; ++ks) q += *(const f32x4*)((const float*)(a->ws + WS_PART) + ((size_t)ks * 256 + b) * 1024 + h * 256 + lane * 4);
    float mx = -1e30f;
#pragma unroll 1
    for (int i0 = 0; i0 < 32; i0 += 8) {
        float sv[8];
#pragma unroll
        for (int i = 0; i < 8; ++i) { const f32x4 k = __builtin_nontemporal_load((const f32x4*)(Kc + (size_t)(wave * 32 + i0 + i) * 1024 + lane * 4));
            sv[i] = (q[0] * k[0] + q[1] * k[1]) + (q[2] * k[2] + q[3] * k[3]); }
#pragma unroll
        for (int i = 0; i < 8; ++i) { const float sres = wave_sum(sv[i]) * 0.0625f; mx = fmaxf(mx, sres); if (lane == 0) sc[wave * 32 + i0 + i] = sres; }
    }
    if (lane == 0) red[wave] = mx;
    __syncthreads();
    float gmx = red[0];
#pragma unroll
    for (int k = 1; k < 8; ++k) gmx = fmaxf(gmx, red[k]);
    float psum = 0.f; f32x4 o = (f32x4){0.f, 0.f, 0.f, 0.f};
#pragma unroll 1
    for (int i0 = 0; i0 < 32; i0 += 8) {
        f32x4 vv[8];
#pragma unroll
        for (int i = 0; i < 8; ++i) vv[i] = __builtin_nontemporal_load((const f32x4*)(Vc + (size_t)(wave * 32 + i0 + i) * 1024 + lane * 4));
#pragma unroll
        for (int i = 0; i < 8; ++i) { const float p = __expf(sc[wave * 32 + i0 + i] - gmx); psum += p; o += vv[i] * p; }
    }
    if (lane == 0) red[8 + wave] = psum;
    *(LAS f32x4*)(op + wave * 256 + lane * 4) = o;
    __syncthreads();
    if (tid < 256) {
        float tot = 0.f, ov = 0.f;
#pragma unroll
        for (int k = 0; k < 8; ++k) { tot += red[8 + k]; ov += op[k * 256 + tid]; }
        OC[(size_t)(MP + b) * 1024 + h * 256 + tid] = f2bf(ov / tot);
    }
    __syncthreads();
}


#define XB_TMO      128
#define XB_XCNT(j)  (256  + 64 * (j))
#define XB_XSUB(j)  (1280 + 64 * (j))
#define XB_XGEN(j)  (2304 + 64 * (j))
#define XB_TOP      3328
#define XB_TOPGEN   3392
#define XCD_BAR_WORDS 3456
#define XB_SPIN_CAP (1u << 20)
__device__ __forceinline__ unsigned xb_ld(unsigned* p)              { return __hip_atomic_load(p, __ATOMIC_RELAXED, __HIP_MEMORY_SCOPE_AGENT); }
__device__ __forceinline__ unsigned xb_add(unsigned* p, unsigned v) { return __hip_atomic_fetch_add(p, v, __ATOMIC_RELAXED, __HIP_MEMORY_SCOPE_AGENT); }
__device__ __forceinline__ unsigned xb_xcc_id() { return (unsigned)__builtin_amdgcn_s_getreg((3 << 11) | 20) & 0xFu; }
#define XB_SPIN(cond, bar) do { unsigned _sp = 0; while (cond) { __builtin_amdgcn_s_sleep(1); \
    if ((++_sp & 255u) == 0u) { if (xb_ld(&(bar)[XB_TMO])) break; if (_sp > XB_SPIN_CAP) { atomicAdd(&(bar)[XB_TMO], 1u); break; } } } } while (0)
struct XcdBarrier { unsigned* bar; unsigned x; volatile LAS unsigned* st; };
__device__ __forceinline__ XcdBarrier xcd_barrier_post(unsigned* bar, volatile LAS unsigned* st) {
    XcdBarrier b; b.bar = bar; b.x = xb_xcc_id(); b.st = st;
    if (threadIdx.x == 0) (void)xb_add(&bar[XB_XCNT(b.x)], 1u);
    return b;
}
__device__ __forceinline__ void xcd_barrier_complete(unsigned* bar, unsigned x, unsigned& nloc, unsigned& nx) {
    const unsigned G = gridDim.x * gridDim.y * gridDim.z;
    unsigned sum, cnt, mine, sp = 0u;
    for (;;) {
        sum = 0u; cnt = 0u; mine = 0u;
#pragma unroll
        for (unsigned j = 0; j < 16; ++j) { const unsigned c = xb_ld(&bar[XB_XCNT(j)]); sum += c; cnt += (c > 0u) ? 1u : 0u; mine = (j == x) ? c : mine; }
        if (sum == G) break;
        __builtin_amdgcn_s_sleep(1);
        if ((++sp & 255u) == 0u) { if (xb_ld(&bar[XB_TMO])) break; if (sp > XB_SPIN_CAP) { atomicAdd(&bar[XB_TMO], 1u); break; } }
    }
    nloc = mine > 0u ? mine : 1u; nx = cnt > 0u ? cnt : 1u;
}
__device__ __forceinline__ void xcd_barrier(const XcdBarrier& b) {
    asm volatile("s_waitcnt vmcnt(0)" ::: "memory");
    __syncthreads();
    if (threadIdx.x == 0) {
        unsigned* bar = b.bar;
        __builtin_amdgcn_s_waitcnt(0);
        unsigned nloc = b.st[0], nx = b.st[1];
        if (nloc == 0u) { xcd_barrier_complete(bar, b.x, nloc, nx); b.st[0] = nloc; b.st[1] = nx; }
        const unsigned old = xb_add(&bar[XB_XSUB(b.x)], 1u);
        const unsigned gen = old / nloc;
        if (old + 1u == (gen + 1u) * nloc) {
            __builtin_amdgcn_fence(__ATOMIC_RELEASE, "agent");
            asm volatile("s_waitcnt vmcnt(0)" ::: "memory");
            const unsigned og = xb_add(&bar[XB_TOP], 1u);
            const unsigned tg = og / nx;
            if (og + 1u == (tg + 1u) * nx) xb_add(&bar[XB_TOPGEN], 1u);
            else XB_SPIN(xb_ld(&bar[XB_TOPGEN]) == tg, bar);
            __builtin_amdgcn_fence(__ATOMIC_ACQUIRE, "agent");
            xb_add(&bar[XB_XGEN(b.x)], 1u);
            asm volatile("s_waitcnt vmcnt(0)" ::: "memory");
        } else {
            XB_SPIN(xb_ld(&bar[XB_XGEN(b.x)]) == gen, bar);
            __builtin_amdgcn_fence(__ATOMIC_ACQUIRE, "agent");
            asm volatile("s_waitcnt vmcnt(0)" ::: "memory");
        }
    }
    __syncthreads();
}

__global__ void __launch_bounds__(512, 2) fwd_kernel(Args a_) {
    extern __shared__ __attribute__((aligned(16))) unsigned char lds_raw[];
    LAS unsigned char* lds = (LAS unsigned char*)lds_raw;
    cg::grid_group grid = cg::this_grid();
    const int G = gridDim.x, bx = blockIdx.x;
    const int ph_lo = a_.ph_lo, ph_hi = a_.ph_hi;
    int rep_done = 0; (void)rep_done;
    volatile LAS unsigned* bst = (volatile LAS unsigned*)(lds + LDS_STAGE);
    if (threadIdx.x < 2) bst[threadIdx.x] = 0u;
    __syncthreads();
    const XcdBarrier xb = xcd_barrier_post((unsigned*)(a_.ws + WS_BAR), bst);
    if (ph_lo < 0) grid.sync();
    for (int ph = ph_lo; ph < ph_hi; ++ph) {
        ArgsP a = (ArgsP)__builtin_amdgcn_kernarg_segment_ptr();
        asm volatile("" : "+s"(a));
        unsigned char* ws = a->ws;
        bf16_t* XB = (bf16_t*)(ws + WS_XB); bf16_t* WIDE = (bf16_t*)(ws + WS_WIDE); bf16_t* OC = (bf16_t*)(ws + WS_OC);
        bf16_t* QB = (bf16_t*)(ws + WS_QB); bf16_t* PB = (bf16_t*)(ws + WS_PB);
        float* T = (float*)(ws + WS_T); float* XRES = (float*)(ws + WS_XRES);
        if (ph == 0) { prep_phase(a, lds); }
        else {
            const int l = (ph - 1) / 17 >= 1 ? 1 : 0;
            const int q = ph - 1 - l * 17;
            int code;
            if (l == 0) code = q; else code = q < 3 ? q : (q < 8 ? 100 + (q - 3) : q + 1);
            EpiA e{};
            if (code == 0 || code == 14) {
                const int ls = l * 2 + (code == 14 ? 1 : 0);
                if (ph == 1) {
                    GemmP g = mk_gemm(ws + WS_MEMB, 1024, ws + WS_WKV, 1024, 1024, 8, 16); g.rev = 1;
                    EpiA ek{}; ek.f0 = a->out; ek.b0 = (bf16_t*)(ws + WS_KB); ek.b1 = (bf16_t*)(ws + WS_VT);
                    gemm_phase<EPI_KV>(lds, g, ek);
                }
                GemmP g = mk_gemm(XB, 1024, (bf16_t*)(ws + WS_WGU) + (size_t)ls * 5632 * 1024, 1024, 1024, MT / BM, 22);
                e.b0 = WIDE; e.ldc = FF;
                gemm_phase<EPI_SWIGLU>(lds, g, e);
            } else if (code == 1 || code == 15) {
                const int ls = l * 2 + (code == 15 ? 1 : 0);
                const bf16_t* Wd = (bf16_t*)(ws + WS_WDN) + (size_t)ls * 1024 * 2816;
                GemmP g = mk_gemm(WIDE, FF, Wd, FF, FF, MP / BM, 4);
                e.b0 = (bf16_t*)T; e.b1 = XB; e.s0 = ALPHA; e.s1 = 0.5f; e.f0 = (float*)(ws + WS_PART); g.nsplit = 11;
                gemm_phase<EPI_RES>(lds, g, e);
            } else if (code == 2) { ln_phase(a, l, 0, false, 11, 0.5f); }
            else if (code == 16) { ln_phase(a, l, 3, l == 1, 11, 0.5f); }
            else if (code == 8 || code == 104) { ln_phase(a, l, 1, false, 4, 1.f); }
            else if (code == 13) { ln_phase(a, l, 2, false, 4, 1.f); }
            else if (code == 3) {
                GemmP g = mk_gemm(XB, 1024, ws + WS_WABIN, 1024, 1024, MT / BM, ABN / BM);
                e.b0 = WIDE; e.ldc = ABN; e.flag = 0;
                gemm_phase<EPI_BF16>(lds, g, e);
            } else if (code == 4) {
                for (int it = bx; it < 1024; it += G) gdn_prep_item(a, lds, it);
                for (int it = bx; it < 512; it += G) gdn_sample_item(a, lds, it);
            } else if (code == 5) {
                for (int it = bx; it < 256; it += G) { int item = it; if (G == 256) { const int xcd = it & 7, k = it >> 3; item = (((k >> 3) * 8 + xcd) << 3) | (k & 7); } gdn_scan_item(a, lds, item); }
            } else if (code == 6) {
                for (int it = bx; it < 512; it += G) conf_item(a, lds, it);
                for (int it = bx; it < 128; it += G) conf_sample_item(a, lds, it);
                gdn_finish_phase(a);
            } else if (code == 7) {
                GemmP g = mk_gemm(OC, 1024, ws + WS_WABOUT, 1024, 1024, MP / BM, 4);
                e.b0 = (bf16_t*)T; e.b1 = XB; e.s0 = ALPHA; e.s1 = 1.f; e.f0 = (float*)(ws + WS_PART); g.nsplit = 4;
                gemm_phase<EPI_RES>(lds, g, e);
            } else if (code == 100) {
                GemmP g = mk_gemm(XB, 1024, ws + WS_WGMIN, 1024, 1024, MT / BM, 8);
                e.b0 = WIDE; e.ldc = 2048; e.flag = 1;
                gemm_phase<EPI_BF16>(lds, g, e);
            } else if (code == 101) { gm_ln_phase(a); }
            else if (code == 102) { for (int it = bx; it < 128 * 16; it += G) gm_mix_item(a, lds, it); }
            else if (code == 103) {
                GemmP g = mk_gemm(OC, 1024, ws + WS_WGMOUT, 1024, 1024, MP / BM, 4);
                e.b0 = (bf16_t*)T; e.b1 = XB; e.s0 = ALPHA; e.s1 = 1.f; e.f0 = (float*)(ws + WS_PART); g.nsplit = 4;
                gemm_phase<EPI_RES>(lds, g, e);
            } else if (code == 9) {
                const bf16_t* Wq = (bf16_t*)(ws + WS_WQ) + (size_t)l * 1024 * 1024;
                GemmP g = mk_gemm(XB, 1024, Wq, 1024, 1024, MP / BM, 4);
                e.b0 = QB; e.ldc = 1024; e.flag = 0; e.f0 = (float*)(ws + WS_PART); g.nsplit = 4;
                gemm_phase<EPI_BF16>(lds, g, e);
            } else if (code == 10) {
                GemmP g = mk_gemm(QB, 1024, ws + WS_KB, 1024, 256, 64, 4); g.A = (const char*)QB; g.B = (const char*)((bf16_t*)(ws + WS_KB) + (size_t)l * 8 * 256 * 1024);
                g.a_pm = (long)256 * 1024 * 2; g.a_pn = 256 * 2; g.b_pb = (long)256 * 1024 * 2; g.b_pn = 256 * 2; g.lda = 1024; g.ldb = 1024; g.nt = 4; g.nM = 64; g.nN = 4;
                e.b0 = PB; e.f0 = (float*)(ws + WS_ROWSUM) + (size_t)l * MP * 4;
                gemm_phase<EPI_SCORES>(lds, g, e);
                for (int it = bx; it < 512; it += G) xattn_sample_item(a, lds, l, it);
#if defined(DUP_CLASS) && DUP_CLASS == 8
                for (int it = bx; it < 512; it += G) xattn_sample_item(a, lds, l, it);
#endif
            } else if (code == 11) {
                GemmP g = mk_gemm(PB, 1024, ws + WS_VT, 256, 256, 64, 4); g.A = (const char*)PB; g.B = (const char*)((bf16_t*)(ws + WS_VT) + (size_t)l * 8 * 1024 * 256);
                g.a_pm = (long)256 * 1024 * 2; g.a_pn = 256 * 2; g.b_pb = (long)1024 * 256 * 2; g.b_pn = (long)256 * 256 * 2; g.lda = 1024; g.ldb = 256; g.nt = 4; g.nM = 64; g.nN = 4;
                e.b0 = OC; e.f1 = (const float*)(ws + WS_ROWSUM) + (size_t)l * MP * 4;
                gemm_phase<EPI_PV>(lds, g, e);
            } else if (code == 12) {
                const bf16_t* Wo = (bf16_t*)(ws + WS_WO) + (size_t)l * 1024 * 1024;
                GemmP g = mk_gemm(OC, 1024, Wo, 1024, 1024, MP / BM, 4);
                e.b0 = (bf16_t*)T; e.b1 = XB; e.s0 = ALPHA; e.s1 = 1.f; e.f0 = (float*)(ws + WS_PART); g.nsplit = 4;
                gemm_phase<EPI_RES>(lds, g, e);
            }
        }
#ifdef DUP_CLASS
        {
            int code_ = -1;
            if (ph > 0) { const int l_ = (ph - 1) / 17 >= 1 ? 1 : 0, q_ = ph - 1 - l_ * 17; code_ = l_ == 0 ? q_ : (q_ < 3 ? q_ : (q_ < 8 ? 100 + (q_ - 3) : q_ + 1)); }
            bool dup = false;
            if (DUP_CLASS == 1) dup = (code_ == 0 || code_ == 1 || code_ == 3 || code_ == 7 || code_ == 9 || code_ == 11 || code_ == 12 || code_ == 14 || code_ == 15 || code_ == 100 || code_ == 103);
            if (DUP_CLASS == 2) dup = (ph == 0 || code_ == 2 || code_ == 8 || code_ == 13 || code_ == 16 || code_ == 104 || code_ == 101);
            if (DUP_CLASS == 3) dup = (code_ == 4 || code_ == 5 || code_ == 6 || code_ == 102);
            if (DUP_CLASS == 4) dup = (code_ == 5);
            if (DUP_CLASS == 5) dup = (ph == 0);
            if (DUP_CLASS == 6) dup = (code_ == 4);
            if (DUP_CLASS == 9) dup = (code_ == 6);
            if (DUP_CLASS == 11) dup = (code_ == 0 || code_ == 14);
            if (DUP_CLASS == 12) dup = (code_ == 1 || code_ == 15);
            if (DUP_CLASS == 13) dup = (code_ == 7 || code_ == 103 || code_ == 12 || code_ == 9);
            if (DUP_CLASS == 10) dup = (code_ == 102 || code_ == 101);
            if (dup && !rep_done) { rep_done = 1; --ph; continue; }
            rep_done = 0;
        }
#endif
        if (ph + 1 < ph_hi) xcd_barrier(xb);
#if defined(DUP_CLASS) && DUP_CLASS == 7
        if (ph + 1 < ph_hi) xcd_barrier(xb);
#endif
    }
#ifdef DIAG_HI
    {
        grid.sync();
        ArgsP a = (ArgsP)__builtin_amdgcn_kernarg_segment_ptr();
        const float* XR = (const float*)(a->ws + WS_XRES); float* o = a->out;
        for (size_t i = (size_t)blockIdx.x * 512 + threadIdx.x; i < (size_t)MV * 1024; i += (size_t)gridDim.x * 512) { float vv = (i < (size_t)8 * 4 * 128 * 128) ? a->out[O_DNS_P + i] * 1000.37f : 0.f; o[i] = vv - floorf(vv); }
    }
#endif
}

extern "C" void kernel_launch(void* const* d_in, const int* in_sizes, int n_in, void* d_out, int out_size, void* d_ws, size_t ws_size, hipStream_t stream) {
    static int grid = 0;
    if (grid == 0) {
        if (n_in != 33 || (size_t)out_size != O_END || ws_size < WS_END) { fprintf(stderr, "kernel_launch: unexpected shapes n_in %d out %d (want %zu) ws %zu (want %zu)\n", n_in, out_size, (size_t)O_END, ws_size, (size_t)WS_END); grid = -1; return; }
        int dev = 0, cus = 0, per_cu = 0;
        hipGetDevice(&dev);
        hipDeviceGetAttribute(&cus, hipDeviceAttributeMultiprocessorCount, dev);
        if (hipFuncSetAttribute((const void*)fwd_kernel, hipFuncAttributeMaxDynamicSharedMemorySize, LDS_BYTES) != hipSuccess) { fprintf(stderr, "kernel_launch: hipFuncSetAttribute failed\n"); grid = -1; return; }
        if (hipOccupancyMaxActiveBlocksPerMultiprocessor(&per_cu, (const void*)fwd_kernel, 512, LDS_BYTES) != hipSuccess || per_cu < 1) { fprintf(stderr, "kernel_launch: occupancy query says %d\n", per_cu); per_cu = 1; }
        (void)hipGetLastError();
        grid = cus;
    }
    if (grid < 0) return;
    if (hipMemsetAsync((char*)d_ws + WS_BAR, 0, (size_t)3456 * 4, stream) != hipSuccess) { fprintf(stderr, "kernel_launch: memset of barrier words failed\n"); return; }
    Args a{};
    for (int i = 0; i < 33; ++i) a.in[i] = (const float*)d_in[i];
    a.out = (float*)d_out; a.ws = (unsigned char*)d_ws;
#if N_PER_PHASE_LAUNCH
    for (int ph = 0; ph < NPHASES; ++ph) {
        a.ph_lo = ph; a.ph_hi = ph + 1;
        void* args[] = {&a};
        hipError_t e = hipLaunchCooperativeKernel((const void*)fwd_kernel, dim3(grid), dim3(512), args, LDS_BYTES, stream);
        if (e != hipSuccess) { fprintf(stderr, "launch failed: %s\n", hipGetErrorString(e)); return; }
    }
#else
#ifdef DIAG_HI
    a.ph_lo = 0; a.ph_hi = DIAG_HI;
#else
    a.ph_lo = 0; a.ph_hi = NPHASES;
#endif
    void* args[] = {&a};
    hipError_t e = hipLaunchCooperativeKernel((const void*)fwd_kernel, dim3(grid), dim3(512), args, LDS_BYTES, stream);
    if (e != hipSuccess) fprintf(stderr, "cooperative launch failed: %s (grid %d)\n", hipGetErrorString(e), grid);
#endif
}
```
